# Optimizing an MI355X kernel written in HIP

```python
import math
import jax, jax.numpy as jnp
from jax import lax
import numpy as np

D_MODEL = 1024
BATCH = 16
SEQ = 2048
DEPTH = 1

HEAD_DIM = 64
BLOCK = 128
A_Q_HEADS = 16
A_KV_HEADS = 2
A_GROUP = A_Q_HEADS // A_KV_HEADS
A_WINDOW = 128
B_PATTERNS = ((128, 1), (512, 4), (2048, 16))
B_HEADS_PER_GROUP = 8
B_HEADS = B_HEADS_PER_GROUP * len(B_PATTERNS)
A_Q_W = A_Q_HEADS * HEAD_DIM
A_KV_W = A_KV_HEADS * HEAD_DIM
B_W = B_HEADS * HEAD_DIM
B_OUT_W = B_HEADS_PER_GROUP * HEAD_DIM
IN_W = A_Q_W + 2 * A_KV_W + 3 * B_W + 2 * D_MODEL
D_FF = -(-8 * D_MODEL // (3 * 256)) * 256
ROPE_THETA = 10000.0
LN_EPS = 1e-5
DEEPNORM_ALPHA = (2 * DEPTH) ** 0.25
DEEPNORM_BETA = (8 * DEPTH) ** -0.25
NEG_INF = -1e30

kernel_name = "hybrid_swa_sink_dilated_gated_deepnorm_adaln"


def layer_norm(x, g, b):
    xf = x.astype(jnp.float32)
    mu = jnp.mean(xf, axis=-1, keepdims=True)
    xc = xf - mu
    var = jnp.mean(xc * xc, axis=-1, keepdims=True)
    y = xc * lax.rsqrt(var + LN_EPS)
    return (y * g.astype(jnp.float32) + b.astype(jnp.float32)).astype(x.dtype)


def rope(x, positions):
    half = HEAD_DIM // 2
    inv = ROPE_THETA ** (-jnp.arange(half, dtype=jnp.float32) / half)
    ang = positions.astype(jnp.float32)[..., None] * inv
    cos = jnp.cos(ang)[:, :, None, :]
    sin = jnp.sin(ang)[:, :, None, :]
    xf = x.astype(jnp.float32)
    x1, x2 = xf[..., :half], xf[..., half:]
    out = jnp.concatenate([x1 * cos - x2 * sin, x2 * cos + x1 * sin], axis=-1)
    return out.astype(x.dtype)


def banded_window_attention(q, k, v, n_back, sink=None):
    N, T, Hkv, G, dh = q.shape
    nblk = -(-T // BLOCK)
    pad = nblk * BLOCK - T
    qp = jnp.pad(q, ((0, 0), (0, pad), (0, 0), (0, 0), (0, 0)))
    kp = jnp.pad(k, ((0, 0), (BLOCK, pad), (0, 0), (0, 0)))
    vp = jnp.pad(v, ((0, 0), (BLOCK, pad), (0, 0), (0, 0)))
    qb = qp.reshape(N, nblk, BLOCK, Hkv, G, dh)
    kb = kp.reshape(N, nblk + 1, BLOCK, Hkv, dh)
    vb = vp.reshape(N, nblk + 1, BLOCK, Hkv, dh)
    kw = jnp.concatenate([kb[:, :-1], kb[:, 1:]], axis=2)
    vw = jnp.concatenate([vb[:, :-1], vb[:, 1:]], axis=2)
    s = jnp.einsum('nbqhgd,nbkhd->nbhgqk', qb, kw,
                   preferred_element_type=jnp.float32) * (dh ** -0.5)
    qi = jnp.arange(BLOCK)[:, None]
    ki = jnp.arange(2 * BLOCK)[None, :]
    dist = qi + BLOCK - ki
    kpos = jnp.arange(nblk)[:, None, None] * BLOCK + ki[None] - BLOCK
    mask = (dist >= 0) & (dist <= n_back) & (kpos >= 0)
    s = jnp.where(mask[None, :, None, None], s, NEG_INF)
    m = jnp.max(s, axis=-1)
    if sink is not None:
        sk = sink.astype(jnp.float32).reshape(Hkv, G)[None, None, :, :, None]
        m = jnp.maximum(m, sk)
    p = jnp.exp(s - m[..., None])
    denom = jnp.sum(p, axis=-1)
    if sink is not None:
        denom = denom + jnp.exp(sk - m)
    o = jnp.einsum('nbhgqk,nbkhd->nbqhgd', p, vw.astype(jnp.float32))
    denom_t = jnp.moveaxis(denom, -1, 2)
    o = o / denom_t[..., None]
    lse = jnp.moveaxis(m, -1, 2) + jnp.log(denom_t)
    o = o.reshape(N, nblk * BLOCK, Hkv, G, dh)[:, :T]
    lse = lse.reshape(N, nblk * BLOCK, Hkv, G)[:, :T]
    return o.astype(q.dtype), lse


def dilated_attention(q, k, v, window, dilation):
    Bn, T, H, dh = q.shape
    r = dilation
    tsub = -(-T // r)
    pad = tsub * r - T

    def to_strided(t):
        t = jnp.pad(t, ((0, 0), (0, pad), (0, 0), (0, 0)))
        return t.reshape(Bn, tsub, r, H, dh).transpose(0, 2, 1, 3, 4).reshape(Bn * r, tsub, H, dh)

    o, lse = banded_window_attention(to_strided(q)[:, :, :, None], to_strided(k), to_strided(v),
                                     window // r)
    o = o[:, :, :, 0].reshape(Bn, r, tsub, H, dh).transpose(0, 2, 1, 3, 4).reshape(Bn, tsub * r, H, dh)[:, :T]
    lse = lse[:, :, :, 0].reshape(Bn, r, tsub, H).transpose(0, 2, 1, 3).reshape(Bn, tsub * r, H)[:, :T]
    return o, lse


def mixer(u, positions, w_in, sinks, w_branch_a, w_branch_b, w_o):
    Bn, T, _ = u.shape
    proj = jnp.einsum('btd,de->bte', u, w_in)
    sizes = [A_Q_W, A_KV_W, A_KV_W, B_W, B_W, B_W, D_MODEL]
    offs, acc = [], 0
    for s_ in sizes:
        acc += s_
        offs.append(acc)
    qa, ka, va, qb, kb, vb, ga, gb = jnp.split(proj, offs, axis=-1)

    qa = rope(qa.reshape(Bn, T, A_Q_HEADS, HEAD_DIM), positions).reshape(Bn, T, A_KV_HEADS, A_GROUP, HEAD_DIM)
    ka = rope(ka.reshape(Bn, T, A_KV_HEADS, HEAD_DIM), positions)
    va = va.reshape(Bn, T, A_KV_HEADS, HEAD_DIM)
    oa, _ = banded_window_attention(qa, ka, va, A_WINDOW - 1, sinks)
    ya = jnp.einsum('bte,ed->btd', oa.reshape(Bn, T, A_Q_W), w_branch_a)

    qb = rope(qb.reshape(Bn, T, B_HEADS, HEAD_DIM), positions)
    kb = rope(kb.reshape(Bn, T, B_HEADS, HEAD_DIM), positions)
    vb = vb.reshape(Bn, T, B_HEADS, HEAD_DIM)
    outs, lses = [], []
    for g, (window, dil) in enumerate(B_PATTERNS):
        sl = slice(g * B_HEADS_PER_GROUP, (g + 1) * B_HEADS_PER_GROUP)
        o_g, l_g = dilated_attention(qb[:, :, sl], kb[:, :, sl], vb[:, :, sl], window, dil)
        outs.append(o_g)
        lses.append(l_g)
    o_all = jnp.stack(outs).astype(jnp.float32)
    wts = jax.nn.softmax(jnp.stack(lses), axis=0)
    ob = jnp.sum(wts[..., None] * o_all, axis=0).astype(u.dtype)
    yb = jnp.einsum('bte,ed->btd', ob.reshape(Bn, T, B_OUT_W), w_branch_b)

    merged = jax.nn.sigmoid(ga) * ya + jax.nn.sigmoid(gb) * yb
    return jnp.einsum('btd,de->bte', merged, w_o)


def swiglu(u, w_gate_up, w_down):
    h = jnp.einsum('btd,df->btf', u, w_gate_up)
    hg, hu = jnp.split(h, 2, axis=-1)
    return jnp.einsum('btf,fd->btd', jax.nn.silu(hg) * hu, w_down)


def setup_inputs(seed: int = 0) -> dict:
    key = jax.random.key(seed)
    ks = jax.random.split(key, 20)
    f32 = jnp.float32
    nrm = lambda k, shape, scale: jax.random.normal(k, shape, f32) * scale
    x = jax.random.normal(ks[0], (BATCH, SEQ, D_MODEL), f32)
    c = jax.random.normal(ks[1], (BATCH, D_MODEL), f32)
    offset = jax.random.randint(ks[2], (BATCH, 1), 0, 1024, dtype=jnp.int32)
    positions = offset + jnp.arange(SEQ, dtype=jnp.int32)[None, :]
    return {
        "x": x,
        "c": c,
        "positions": positions,
        "w_ada": nrm(ks[3], (DEPTH, D_MODEL, 6 * D_MODEL), 0.1 * D_MODEL ** -0.5),
        "b_ada": nrm(ks[4], (DEPTH, 6 * D_MODEL), 0.01),
        "w_in": nrm(ks[5], (DEPTH, D_MODEL, IN_W), D_MODEL ** -0.5),
        "sinks": nrm(ks[6], (DEPTH, A_Q_HEADS), 1.0),
        "w_branch_a": nrm(ks[7], (DEPTH, A_Q_W, D_MODEL), A_Q_W ** -0.5),
        "w_branch_b": nrm(ks[8], (DEPTH, B_OUT_W, D_MODEL), B_OUT_W ** -0.5),
        "w_o": nrm(ks[9], (DEPTH, D_MODEL, D_MODEL), DEEPNORM_BETA * D_MODEL ** -0.5),
        "ln1_g": 1.0 + nrm(ks[10], (DEPTH, D_MODEL), 0.02),
        "ln1_b": nrm(ks[11], (DEPTH, D_MODEL), 0.02),
        "w_gate_up": nrm(ks[12], (DEPTH, D_MODEL, 2 * D_FF), D_MODEL ** -0.5),
        "w_down": nrm(ks[13], (DEPTH, D_FF, D_MODEL), DEEPNORM_BETA * D_FF ** -0.5),
        "ln2_g": 1.0 + nrm(ks[14], (DEPTH, D_MODEL), 0.02),
        "ln2_b": nrm(ks[15], (DEPTH, D_MODEL), 0.02),
    }


def reference(x, c, positions, w_ada, b_ada, w_in, sinks, w_branch_a, w_branch_b, w_o,
              ln1_g, ln1_b, w_gate_up, w_down, ln2_g, ln2_b):
    c_act = jax.nn.silu(c)
    for l in range(DEPTH):
        mod = (jnp.einsum('bd,de->be', c_act, w_ada[l]) + b_ada[l])[:, None, :]
        shift_m, scale_m, gate_m, shift_f, scale_f, gate_f = jnp.split(mod, 6, axis=-1)
        u = x * (1.0 + scale_m) + shift_m
        y = mixer(u, positions, w_in[l], sinks[l], w_branch_a[l], w_branch_b[l], w_o[l])
        x = layer_norm(DEEPNORM_ALPHA * x + (1.0 + gate_m) * y, ln1_g[l], ln1_b[l])
        u = x * (1.0 + scale_f) + shift_f
        y = swiglu(u, w_gate_up[l], w_down[l])
        x = layer_norm(DEEPNORM_ALPHA * x + (1.0 + gate_f) * y, ln2_g[l], ln2_b[l])
    return x
```

```cpp
#include <hip/hip_runtime.h>
#include <hip/hip_cooperative_groups.h>
#include <cstdio>
#include <cstdint>
namespace cg = cooperative_groups;
namespace pg8 {
#define PG8_LAS __attribute__((address_space(3)))
typedef unsigned short bf16_t;
typedef short bf16x8 __attribute__((ext_vector_type(8)));
typedef float f32x4 __attribute__((ext_vector_type(4)));
typedef unsigned u32x4 __attribute__((ext_vector_type(4)));
constexpr int BM = 256, BK = 64, HALF = 128, HTB = HALF * BK * 2  , STAGE_BYTES = 8 * HTB, NXCD = 8, WGM = 8;

__host__ __device__ __forceinline__ int lds_byte(int r, int c) { const int st = (r >> 4) * 2 + (c >> 5), rr = r & 15, cc = c & 31, ob = rr * 64 + cc * 2; return st * 1024 + (ob ^ (((ob >> 9) & 1) << 5)); }
__host__ __device__ __forceinline__ void stage_rc(int b, int& R, int& C) { const int st = b / 1024, sb = b % 1024, swz = sb ^ (((sb >> 9) & 1) << 5); R = (st >> 1) * 16 + swz / 64; C = (st & 1) * 32 + (swz % 64) / 2; }
__host__ __device__ __forceinline__ int perm32(int rho) { const int n = rho >> 4, i = rho & 15; return 8 * (i >> 2) + 4 * n + (i & 3); }

struct Unit { int pm, pn; };
struct Gemm { const bf16_t* A; const bf16_t* Bt; int M, N, K; };

struct StaticOrder {
    int nM, nN, nwg, G, c;
    __host__ __device__ void init(int M, int N, int G_, int c_) { nM = M / BM; nN = N / BM; nwg = nM * nN; G = G_; c = c_; }
    __host__ __device__ bool next(int i, Unit& u) const {
        const long L = (long)i * G + c; if (L >= nwg) return false;
        int wgid = (int)L; { const int q = nwg / NXCD, r = nwg % NXCD, xcd = wgid % NXCD, off = wgid / NXCD; wgid = (xcd < r ? xcd * (q + 1) : r * (q + 1) + (xcd - r) * q) + off; }
        const int nig = WGM * nN, gid = wgid / nig, fm = gid * WGM, gsz = (nM - fm) < WGM ? (nM - fm) : WGM;
        u.pm = fm + ((wgid % nig) % gsz); u.pn = (wgid % nig) / gsz; return true;
    }
    __device__ __forceinline__ void a_ready(const Unit&) const {}
    __device__ __forceinline__ void done(const Unit&) const {}
};

__device__ __forceinline__ unsigned cvt_pk_bf16(float lo, float hi) { unsigned r; asm volatile("v_cvt_pk_bf16_f32 %0, %1, %2" : "=v"(r) : "v"(lo), "v"(hi)); return r; }
typedef float f32x2 __attribute__((ext_vector_type(2)));
template <class Epi, class Sched, bool ALIGN_EPI = false, bool SP2 = false>
__device__ __forceinline__ void gemm_phase(PG8_LAS unsigned char* lds, const Gemm g, const Sched& S, const Epi& E) {
    const int tid = threadIdx.x, wid = __builtin_amdgcn_readfirstlane(tid >> 6), lane = tid & 63, wr = wid >> 2, wc = wid & 3, fr = lane & 15, fq = lane >> 4;
    const int K = g.K, nt = K / BK;
    unsigned voffA[2], voffB[2];
#pragma unroll
    for (int i = 0; i < 2; ++i) { int R, C; stage_rc(tid * 16 + i * 8192, R, C); const int Rb = Epi::PERM ? ((R & ~31) + perm32(R & 31)) : R;
        voffA[i] = (unsigned)(R * K + C) * 2u; voffB[i] = (unsigned)(Rb * K + C) * 2u; }
    const size_t kstep = (size_t)(BK * 2);
    const size_t hstep = (size_t)HALF * K * 2;
    const size_t tstep = 2 * hstep;
    const unsigned ldsw = (unsigned)wid * 1024u;
    const int aoff = lds_byte(wr * 64 + fr, fq * 8), boff = lds_byte(wc * 32 + fr, fq * 8);
#define PG8_SA(b, h) (((b) * 2 + (h)) * HTB)
#define PG8_SB(b, h) ((4 + (b) * 2 + (h)) * HTB)
#define PG8_STAGE(bufoff, gbase, voff) do { _Pragma("unroll") for (int _i = 0; _i < 2; ++_i) \
        __builtin_amdgcn_global_load_lds((const unsigned*)((const char*)(gbase) + (voff)[_i]), (PG8_LAS unsigned*)(lds + (bufoff) + ldsw + _i * 8192), 16, 0, 0); } while (0)
#define PG8_LDA(dst, b, h) do { _Pragma("unroll") for (int m = 0; m < 4; ++m) _Pragma("unroll") for (int k = 0; k < 2; ++k) dst[m][k] = *(const PG8_LAS bf16x8*)(lds + PG8_SA(b, h) + aoff + m * 2048 + k * 1024); } while (0)
#define PG8_LDB(dst, b, h) do { _Pragma("unroll") for (int n = 0; n < 2; ++n) _Pragma("unroll") for (int k = 0; k < 2; ++k) dst[n][k] = *(const PG8_LAS bf16x8*)(lds + PG8_SB(b, h) + boff + n * 2048 + k * 1024); } while (0)
#define PG8_MMA(ai, bj, At, Bt) do { __builtin_amdgcn_s_setprio(1); _Pragma("unroll") for (int m = 0; m < 4; ++m) _Pragma("unroll") for (int n = 0; n < 2; ++n) _Pragma("unroll") for (int k = 0; k < 2; ++k) \
        acc[ai][bj][m][n] = __builtin_amdgcn_mfma_f32_16x16x32_bf16(Bt[n][k], At[m][k], acc[ai][bj][m][n], 0, 0, 0); __builtin_amdgcn_s_setprio(0); } while (0)
#define PG8_WAIT_V(n) asm volatile("s_waitcnt vmcnt(" #n ")" ::: "memory")
#define PG8_WAIT_L(n) asm volatile("s_waitcnt lgkmcnt(" #n ")" ::: "memory")
#define PG8_BAR __builtin_amdgcn_s_barrier()
#define PG8_SCHED __builtin_amdgcn_sched_barrier(0)
    Unit cur, nxt; int ui = 0;
    if (!S.next(0, cur)) return;
    f32x4 acc[2][2][4][2];
#pragma unroll
    for (int a = 0; a < 2; ++a)
#pragma unroll
        for (int b = 0; b < 2; ++b)
#pragma unroll
            for (int m = 0; m < 4; ++m)
#pragma unroll
                for (int n = 0; n < 2; ++n) acc[a][b][m][n] = (f32x4){0.f, 0.f, 0.f, 0.f};
    bf16x8 At[4][2], B0[2][2], B1[2][2];
    const char* cA = (const char*)g.A + (size_t)cur.pm * tstep; const char* cB = (const char*)g.Bt + (size_t)cur.pn * tstep;
    S.a_ready(cur);
    if constexpr (SP2) {
        PG8_STAGE(PG8_SB(0, 0), cB, voffB); PG8_STAGE(PG8_SB(0, 1), cB + hstep, voffB); PG8_STAGE(PG8_SA(0, 0), cA, voffA); PG8_STAGE(PG8_SA(0, 1), cA + hstep, voffA);
        if (wr == 1) PG8_BAR;
        PG8_WAIT_V(2); PG8_BAR;
        PG8_STAGE(PG8_SB(1, 0), cB + kstep, voffB); PG8_STAGE(PG8_SA(1, 0), cA + kstep, voffA); PG8_STAGE(PG8_SB(1, 1), cB + hstep + kstep, voffB);
        PG8_WAIT_V(6); PG8_BAR;
    } else {
        PG8_STAGE(PG8_SB(0, 0), cB, voffB); PG8_STAGE(PG8_SA(0, 0), cA, voffA); PG8_STAGE(PG8_SB(0, 1), cB + hstep, voffB); PG8_STAGE(PG8_SA(0, 1), cA + hstep, voffA);
        if (wr == 1) PG8_BAR;
        PG8_WAIT_V(4); PG8_BAR;
        PG8_STAGE(PG8_SB(1, 0), cB + kstep, voffB); PG8_STAGE(PG8_SA(1, 0), cA + kstep, voffA); PG8_STAGE(PG8_SB(1, 1), cB + hstep + kstep, voffB);
        PG8_WAIT_V(6); PG8_BAR;
    }
    for (;;) {
        const bool has_next = S.next(ui + 1, nxt);
        const char* nA = has_next ? (const char*)g.A + (size_t)nxt.pm * tstep : cA; const char* nB = has_next ? (const char*)g.Bt + (size_t)nxt.pn * tstep : cB;
        for (int t = 0; t < nt; t += 2) {
            const bool last = (t == nt - 2);
            const char* a1 = cA + (size_t)(t + 1) * kstep;
            const char* a2 = last ? nA : cA + (size_t)(t + 2) * kstep; const char* b2 = last ? nB : cB + (size_t)(t + 2) * kstep;
            const char* a3 = a2 + kstep; const char* b3 = b2 + kstep;
            if (last && has_next) S.a_ready(nxt);
            if constexpr (SP2) {
            PG8_LDB(B0, 0, 0); PG8_LDB(B1, 0, 1); PG8_SCHED; PG8_LDA(At, 0, 0); PG8_STAGE(PG8_SA(1, 1), a1 + hstep, voffA);
            PG8_WAIT_V(8); PG8_WAIT_L(0); PG8_BAR; PG8_MMA(0, 0, At, B0); PG8_MMA(0, 1, At, B1); PG8_BAR; PG8_SCHED;
            PG8_LDA(At, 0, 1); PG8_STAGE(PG8_SB(0, 0), b2, voffB); PG8_STAGE(PG8_SB(0, 1), b2 + hstep, voffB); PG8_STAGE(PG8_SA(0, 0), a2, voffA);
            PG8_WAIT_V(8); PG8_WAIT_L(0); PG8_BAR; PG8_MMA(1, 0, At, B0); PG8_MMA(1, 1, At, B1); PG8_BAR; PG8_SCHED;
            PG8_LDB(B0, 1, 0); PG8_LDB(B1, 1, 1); PG8_SCHED; PG8_LDA(At, 1, 0); PG8_STAGE(PG8_SA(0, 1), a2 + hstep, voffA);
            PG8_WAIT_V(8); PG8_WAIT_L(0); PG8_BAR; PG8_MMA(0, 0, At, B0); PG8_MMA(0, 1, At, B1); PG8_BAR; PG8_SCHED;
            PG8_LDA(At, 1, 1); PG8_STAGE(PG8_SB(1, 0), b3, voffB); PG8_STAGE(PG8_SB(1, 1), b3 + hstep, voffB); PG8_STAGE(PG8_SA(1, 0), a3, voffA);
            PG8_WAIT_V(8); PG8_WAIT_L(0); PG8_BAR; PG8_MMA(1, 0, At, B0); PG8_MMA(1, 1, At, B1); PG8_BAR; PG8_SCHED;
            } else {
            PG8_LDB(B0, 0, 0); PG8_SCHED; PG8_LDA(At, 0, 0); PG8_STAGE(PG8_SA(1, 1), a1 + hstep, voffA);
            PG8_WAIT_L(8); PG8_BAR; PG8_WAIT_L(0); PG8_MMA(0, 0, At, B0); PG8_BAR; PG8_SCHED;
            PG8_LDB(B1, 0, 1); PG8_STAGE(PG8_SB(0, 0), b2, voffB);
            PG8_BAR; PG8_WAIT_L(0); PG8_MMA(0, 1, At, B1); PG8_BAR;
            PG8_LDA(At, 0, 1); PG8_STAGE(PG8_SA(0, 0), a2, voffA);
            PG8_BAR; PG8_WAIT_L(0); PG8_MMA(1, 0, At, B0); PG8_BAR; PG8_SCHED;
            PG8_STAGE(PG8_SB(0, 1), b2 + hstep, voffB);
            PG8_WAIT_V(6); PG8_BAR; PG8_MMA(1, 1, At, B1); PG8_BAR;
            PG8_LDB(B0, 1, 0); PG8_SCHED; PG8_LDA(At, 1, 0); PG8_STAGE(PG8_SA(0, 1), a2 + hstep, voffA);
            PG8_WAIT_L(8); PG8_BAR; PG8_WAIT_L(0); PG8_MMA(0, 0, At, B0); PG8_BAR; PG8_SCHED;
            PG8_LDB(B1, 1, 1); PG8_STAGE(PG8_SB(1, 0), b3, voffB);
            PG8_BAR; PG8_WAIT_L(0); PG8_MMA(0, 1, At, B1); PG8_BAR;
            PG8_LDA(At, 1, 1); PG8_STAGE(PG8_SA(1, 0), a3, voffA);
            PG8_BAR; PG8_WAIT_L(0); PG8_MMA(1, 0, At, B0); PG8_BAR; PG8_SCHED;
            PG8_STAGE(PG8_SB(1, 1), b3 + hstep, voffB);
            PG8_WAIT_V(6); PG8_BAR; PG8_MMA(1, 1, At, B1); PG8_BAR;
            }
        }
        if constexpr (ALIGN_EPI) { if (wr == 0) PG8_BAR; }
        if constexpr (!Epi::AFTER_DRAIN) { E(acc, cur, wr, wc, fr, fq); S.done(cur); }
        if (!has_next) break;
#pragma unroll
        for (int a = 0; a < 2; ++a)
#pragma unroll
            for (int b = 0; b < 2; ++b)
#pragma unroll
                for (int m = 0; m < 4; ++m)
#pragma unroll
                    for (int n = 0; n < 2; ++n) acc[a][b][m][n] = (f32x4){0.f, 0.f, 0.f, 0.f};
        cur = nxt; cA = nA; cB = nB; ++ui;
        if constexpr (ALIGN_EPI) { if (wr == 1) PG8_BAR; }
    }
    PG8_WAIT_V(0);
    if constexpr (!ALIGN_EPI) { if (wr == 0) PG8_BAR; }
    PG8_BAR;
    if constexpr (Epi::AFTER_DRAIN) { E.fused(acc, cur, wr, wc, fr, fq, lds, wid, lane); S.done(cur); }
#undef PG8_SA
#undef PG8_SB
#undef PG8_STAGE
#undef PG8_LDA
#undef PG8_LDB
#undef PG8_MMA
#undef PG8_WAIT_V
#undef PG8_WAIT_L
#undef PG8_BAR
#undef PG8_SCHED
}
}

#define LAS __attribute__((address_space(3)))
typedef unsigned short bf16;
typedef float f32x4 __attribute__((ext_vector_type(4)));
typedef float f32x16 __attribute__((ext_vector_type(16)));
typedef unsigned u32x4 __attribute__((ext_vector_type(4)));
typedef unsigned u32x2 __attribute__((ext_vector_type(2)));
typedef short bf16x8 __attribute__((ext_vector_type(8)));
typedef short s16x4 __attribute__((ext_vector_type(4)));
typedef float f32x2v __attribute__((ext_vector_type(2)));

constexpr int NB = 16, T = 2048, D = 1024, M = NB * T;
constexpr int INW = 7936, DFF = 2816, MODW = 6 * D;
constexpr float LOG2E = 1.4426950408889634f;
constexpr float QSCALE = 0.125f * LOG2E;
constexpr float ALPHA = 1.189207115002721f;
constexpr float LN_EPS = 1e-5f;
constexpr int NWAVES = 8;

constexpr size_t MiB = 1u << 20;
constexpr size_t WS_MODP = 0, WS_MOD = 3 * MiB, WS_RSTAT = 3 * MiB + 512 * 1024, WS_LSE = 4 * MiB, WS_ROPE = 8 * MiB, WS_ST1 = 16 * MiB, WS_ST2 = 20 * MiB;
constexpr size_t WS_WIN = 24 * MiB, WS_WA = 40 * MiB, WS_WB = 42 * MiB, WS_WO = 43 * MiB, WS_WGU = 45 * MiB, WS_WD = 56 * MiB;
constexpr size_t WS_U = 64 * MiB, WS_QA = 128 * MiB, WS_KVA = 192 * MiB, WS_QB = 208 * MiB, WS_KB = 304 * MiB, WS_VB = 400 * MiB, WS_END = 496 * MiB;
constexpr size_t WS_OB = 64 * MiB, WS_YAS = 304 * MiB, WS_MERGED = 368 * MiB, WS_Z = 128 * MiB, WS_H = 256 * MiB;
constexpr int LDS_BYTES = 135168;

struct Args {
    const float* x; const float* c; const int* pos; const float* w_ada; const float* b_ada; const float* w_in; const float* sinks;
    const float* w_a; const float* w_b; const float* w_o; const float* ln1g; const float* ln1b; const float* w_gu; const float* w_d;
    const float* ln2g; const float* ln2b; float* out; unsigned char* ws;
};

__device__ __forceinline__ unsigned pk2(float lo, float hi) { return pg8::cvt_pk_bf16(lo, hi); }
__device__ __forceinline__ float bflo(unsigned w) { return __uint_as_float(w << 16); }
__device__ __forceinline__ float bfhi(unsigned w) { return __uint_as_float(w & 0xffff0000u); }
__device__ __forceinline__ float sigmoidf_(float v) { return __builtin_amdgcn_rcpf(1.0f + __builtin_amdgcn_exp2f(-v * LOG2E)); }
__device__ __forceinline__ float wave_sum(float v) {
#pragma unroll
    for (int o = 1; o < 64; o <<= 1) v += __shfl_xor(v, o);
    return v;
}

namespace pg8 {
struct EpiInProj {
    static constexpr bool PERM = true, AFTER_DRAIN = false;
    unsigned char* ws; bf16_t* GA; const f32x4* rope;
    __device__ __forceinline__ void operator()(const f32x4 (&acc)[2][2][4][2], const Unit& u, int wr, int wc, int fr, int fq) const {
        const int pn = u.pn; const int row0 = u.pm * BM + wr * 64 + fr;
        if (pn <= 16) {
            size_t boff; int ldc, cb; float sc = 1.f; bool rope_on = true;
            if (pn < 4) { boff = WS_QA; ldc = 1024; cb = pn * 256; sc = QSCALE; }
            else if (pn == 4) { boff = WS_KVA; ldc = 256; cb = 0; rope_on = (wc < 2); }
            else if (pn < 11) { boff = WS_QB; ldc = 1536; cb = (pn - 5) * 256; sc = QSCALE; }
            else { boff = WS_KB; ldc = 1536; cb = (pn - 11) * 256; }
            bf16_t* base = (bf16_t*)(ws + boff);
            const int col = cb + 64 * wc + 8 * fq;
#pragma unroll
            for (int ai = 0; ai < 2; ++ai)
#pragma unroll
                for (int m = 0; m < 4; ++m) {
                    const int row = row0 + ai * HALF + m * 16;
                    f32x4 a0 = acc[ai][0][m][0], a1 = acc[ai][0][m][1], b0 = acc[ai][1][m][0], b1 = acc[ai][1][m][1];
                    f32x4 o0, o1, p0, p1;
                    if (rope_on) {
                        const f32x4* rp = rope + (size_t)row * 16 + 4 * fq;
                        const f32x4 c0 = rp[0], c1 = rp[1], c2 = rp[2], c3 = rp[3];
                        o0[0] = a0[0] * c0[0] - b0[0] * c0[1]; p0[0] = b0[0] * c0[0] + a0[0] * c0[1];
                        o0[1] = a0[1] * c0[2] - b0[1] * c0[3]; p0[1] = b0[1] * c0[2] + a0[1] * c0[3];
                        o0[2] = a0[2] * c1[0] - b0[2] * c1[1]; p0[2] = b0[2] * c1[0] + a0[2] * c1[1];
                        o0[3] = a0[3] * c1[2] - b0[3] * c1[3]; p0[3] = b0[3] * c1[2] + a0[3] * c1[3];
                        o1[0] = a1[0] * c2[0] - b1[0] * c2[1]; p1[0] = b1[0] * c2[0] + a1[0] * c2[1];
                        o1[1] = a1[1] * c2[2] - b1[1] * c2[3]; p1[1] = b1[1] * c2[2] + a1[1] * c2[3];
                        o1[2] = a1[2] * c3[0] - b1[2] * c3[1]; p1[2] = b1[2] * c3[0] + a1[2] * c3[1];
                        o1[3] = a1[3] * c3[2] - b1[3] * c3[3]; p1[3] = b1[3] * c3[2] + a1[3] * c3[3];
                    } else { o0 = a0; o1 = a1; p0 = b0; p1 = b1; }
                    o0 = o0 * sc; o1 = o1 * sc; p0 = p0 * sc; p1 = p1 * sc;
                    u32x4 w; w.x = cvt_pk_bf16(o0[0], o0[1]); w.y = cvt_pk_bf16(o0[2], o0[3]); w.z = cvt_pk_bf16(o1[0], o1[1]); w.w = cvt_pk_bf16(o1[2], o1[3]);
                    u32x4 v; v.x = cvt_pk_bf16(p0[0], p0[1]); v.y = cvt_pk_bf16(p0[2], p0[3]); v.z = cvt_pk_bf16(p1[0], p1[1]); v.w = cvt_pk_bf16(p1[2], p1[3]);
                    bf16_t* rowp = base + (size_t)row * ldc + col;
                    *(u32x4*)(rowp) = w; *(u32x4*)(rowp + 32) = v;
                }
        } else {
            bf16_t* base; int ldc, cb; const bool sig = (pn >= 23);
            if (pn < 23) { base = (bf16_t*)(ws + WS_VB); ldc = 1536; cb = (pn - 17) * 256; }
            else { base = GA + (pn < 27 ? (size_t)0 : (size_t)M * 1024); ldc = 1024; cb = ((pn - 23) & 3) * 256; }
            const int col = cb + 32 * wc + 8 * fq;
#pragma unroll
            for (int ai = 0; ai < 2; ++ai)
#pragma unroll
                for (int m = 0; m < 4; ++m) {
                    bf16_t* rowp = base + (size_t)(row0 + ai * HALF + m * 16) * ldc + col;
#pragma unroll
                    for (int bj = 0; bj < 2; ++bj) {
                        f32x4 v0 = acc[ai][bj][m][0], v1 = acc[ai][bj][m][1];
                        if (sig) {
#pragma unroll
                            for (int e = 0; e < 4; ++e) { v0[e] = sigmoidf_(v0[e]); v1[e] = sigmoidf_(v1[e]); }
                        }
                        u32x4 w; w.x = cvt_pk_bf16(v0[0], v0[1]); w.y = cvt_pk_bf16(v0[2], v0[3]); w.z = cvt_pk_bf16(v1[0], v1[1]); w.w = cvt_pk_bf16(v1[2], v1[3]);
                        *(u32x4*)(rowp + bj * HALF) = w;
                    }
                }
        }
    }
};
template <bool ADD> struct EpiGate {
    static constexpr bool PERM = true, AFTER_DRAIN = false;
    bf16_t* O; const bf16_t* G; const bf16_t* A;
    __device__ __forceinline__ void operator()(const f32x4 (&acc)[2][2][4][2], const Unit& u, int wr, int wc, int fr, int fq) const {
        const int row0 = u.pm * BM + wr * 64 + fr, col = u.pn * BM + wc * 32 + 8 * fq;
#pragma unroll
        for (int ai = 0; ai < 2; ++ai)
#pragma unroll
            for (int m = 0; m < 4; ++m) {
                const size_t off = (size_t)(row0 + ai * HALF + m * 16) * 1024 + col;
#pragma unroll
                for (int bj = 0; bj < 2; ++bj) {
                    const u32x4 g = *(const u32x4*)(G + off + bj * HALF);
                    f32x4 v0 = acc[ai][bj][m][0], v1 = acc[ai][bj][m][1];
                    v0[0] *= bflo(g.x); v0[1] *= bfhi(g.x); v0[2] *= bflo(g.y); v0[3] *= bfhi(g.y);
                    v1[0] *= bflo(g.z); v1[1] *= bfhi(g.z); v1[2] *= bflo(g.w); v1[3] *= bfhi(g.w);
                    if (ADD) { const u32x4 a = *(const u32x4*)(A + off + bj * HALF);
                        v0[0] += bflo(a.x); v0[1] += bfhi(a.x); v0[2] += bflo(a.y); v0[3] += bfhi(a.y);
                        v1[0] += bflo(a.z); v1[1] += bfhi(a.z); v1[2] += bflo(a.w); v1[3] += bfhi(a.w); }
                    u32x4 w; w.x = cvt_pk_bf16(v0[0], v0[1]); w.y = cvt_pk_bf16(v0[2], v0[3]); w.z = cvt_pk_bf16(v1[0], v1[1]); w.w = cvt_pk_bf16(v1[2], v1[3]);
                    *(u32x4*)(O + off + bj * HALF) = w;
                }
            }
    }
};
template <bool LNIN> struct EpiRes {
    static constexpr bool PERM = false, AFTER_DRAIN = false;
    const float* xin; float* zout; const float* gate  ; f32x2v* stats; const f32x2v* rstat; const float* lng; const float* lnb;
    __device__ __forceinline__ void operator()(const f32x4 (&acc)[2][2][4][2], const Unit& u, int wr, int wc, int fr, int fq) const {
        const int row0 = u.pm * BM + wr * 64 + fr, col0 = u.pn * BM + wc * 32 + 4 * fq;
        const float* gb = gate + (size_t)((u.pm * BM) / T) * MODW + col0;
        f32x4 gv[2][2], lg[2][2], lb[2][2];
#pragma unroll
        for (int bj = 0; bj < 2; ++bj)
#pragma unroll
            for (int n = 0; n < 2; ++n) { gv[bj][n] = *(const f32x4*)(gb + bj * HALF + n * 16) + 1.0f;
                if (LNIN) { lg[bj][n] = *(const f32x4*)(lng + col0 + bj * HALF + n * 16); lb[bj][n] = *(const f32x4*)(lnb + col0 + bj * HALF + n * 16); } }
#pragma unroll
        for (int ai = 0; ai < 2; ++ai)
#pragma unroll
            for (int m = 0; m < 4; ++m) {
                const int row = row0 + ai * HALF + m * 16; const size_t off = (size_t)row * 1024 + col0;
                f32x2v rs; if (LNIN) rs = rstat[row];
                float s = 0.f, q = 0.f;
#pragma unroll
                for (int bj = 0; bj < 2; ++bj)
#pragma unroll
                    for (int n = 0; n < 2; ++n) {
                        f32x4 xi = *(const f32x4*)(xin + off + bj * HALF + n * 16);
                        if (LNIN) xi = (xi - rs.x) * rs.y * lg[bj][n] + lb[bj][n];
                        const f32x4 z = xi * ALPHA + gv[bj][n] * acc[ai][bj][m][n];
                        *(f32x4*)(zout + off + bj * HALF + n * 16) = z;
                        s += (z[0] + z[1]) + (z[2] + z[3]); q += (z[0] * z[0] + z[1] * z[1]) + (z[2] * z[2] + z[3] * z[3]);
                    }
                s += __shfl_xor(s, 16); s += __shfl_xor(s, 32); q += __shfl_xor(q, 16); q += __shfl_xor(q, 32);
                if (fq == 0) stats[(size_t)row * 16 + u.pn * 4 + wc] = (f32x2v){s, q};
            }
    }
};
struct EpiSwiGLU {
    static constexpr bool PERM = true, AFTER_DRAIN = false;
    bf16_t* H;
    __device__ __forceinline__ void operator()(const f32x4 (&acc)[2][2][4][2], const Unit& u, int wr, int wc, int fr, int fq) const {
        const int row0 = u.pm * BM + wr * 64 + fr, col = u.pn * HALF + wc * 32 + 8 * fq;
#pragma unroll
        for (int ai = 0; ai < 2; ++ai)
#pragma unroll
            for (int m = 0; m < 4; ++m) {
                f32x4 o[2];
#pragma unroll
                for (int n = 0; n < 2; ++n)
#pragma unroll
                    for (int e = 0; e < 4; ++e) { const float g = acc[ai][0][m][n][e]; o[n][e] = g * sigmoidf_(g) * acc[ai][1][m][n][e]; }
                u32x4 w; w.x = cvt_pk_bf16(o[0][0], o[0][1]); w.y = cvt_pk_bf16(o[0][2], o[0][3]); w.z = cvt_pk_bf16(o[1][0], o[1][1]); w.w = cvt_pk_bf16(o[1][2], o[1][3]);
                *(u32x4*)(H + (size_t)(row0 + ai * HALF + m * 16) * DFF + col) = w;
            }
    }
};
}

__device__ __forceinline__ void p0_transpose_item(const float* W, int K, int N, bf16* WT, int dst_row0, int src_col0, int kb, LAS float* scr, int lane) {
    const int k0 = 64 * kb;
#pragma unroll 8
    for (int i = 0; i < 32; ++i) { const int kk = 2 * i + (lane >> 5); scr[kk * 33 + (lane & 31)] = W[(size_t)(k0 + kk) * N + src_col0 + (lane & 31)]; }
    asm volatile("s_waitcnt lgkmcnt(0)" ::: "memory");
    const int c = lane & 7;
#pragma unroll
    for (int j = 0; j < 4; ++j) { const int n = (lane >> 3) + 8 * j; const LAS float* s = scr + (8 * c) * 33 + n;
        u32x4 o; o.x = pk2(s[0 * 33], s[1 * 33]); o.y = pk2(s[2 * 33], s[3 * 33]); o.z = pk2(s[4 * 33], s[5 * 33]); o.w = pk2(s[6 * 33], s[7 * 33]);
        *(u32x4*)(WT + (size_t)(dst_row0 + n) * K + k0 + 8 * c) = o; }
    asm volatile("s_waitcnt lgkmcnt(0)" ::: "memory");
}
__device__ __forceinline__ int win_src(int p_abs) {
    const int pn = p_abs >> 8, p = p_abs & 255;
    if (pn <= 16) { const int bj = p >> 7, hh = (p & 127) >> 5; return pn * 256 + 64 * hh + 32 * bj; }
    return p_abs;
}
__device__ __forceinline__ int wgu_src(int p_abs) {
    const int pn = p_abs >> 8, p = p_abs & 255, bj = p >> 7, j = p & 127; return bj * DFF + pn * 128 + j;
}

__device__ __forceinline__ void phase0(const Args& a, LAS unsigned char* lds, int wave, int lane) {
    asm volatile("" : "+v"(lane));
    LAS float* scr = (LAS float*)(lds + wave * 16384);
    const int gw = blockIdx.x * NWAVES + wave, NGW = gridDim.x * NWAVES;
    unsigned char* ws = a.ws;
    for (int it = gw; it < 96 * 8; it += NGW) {
        const int cgp = it % 96, kc = it / 96;
        for (int idx = lane; idx < 2048; idx += 64) { const int b = idx >> 7, k = idx & 127; const float cv = a.c[b * D + kc * 128 + k]; scr[idx] = cv * sigmoidf_(cv); }
        asm volatile("s_waitcnt lgkmcnt(0)" ::: "memory");
        float acc[16];
#pragma unroll
        for (int b = 0; b < 16; ++b) acc[b] = 0.f;
        const float* wp = a.w_ada + (size_t)(kc * 128) * MODW + cgp * 64 + lane;
        for (int k = 0; k < 128; k += 4) {
            const float w0 = wp[(size_t)(k + 0) * MODW], w1 = wp[(size_t)(k + 1) * MODW], w2 = wp[(size_t)(k + 2) * MODW], w3 = wp[(size_t)(k + 3) * MODW];
#pragma unroll
            for (int b = 0; b < 16; ++b) { const f32x4 cv = *(const LAS f32x4*)(scr + b * 128 + k); acc[b] += cv[0] * w0 + cv[1] * w1 + cv[2] * w2 + cv[3] * w3; }
        }
        float* mp = (float*)(ws + WS_MODP) + (size_t)kc * 16 * MODW + cgp * 64 + lane;
        const float bias = (kc == 0) ? a.b_ada[cgp * 64 + lane] : 0.f;
#pragma unroll
        for (int b = 0; b < 16; ++b) mp[(size_t)b * MODW] = acc[b] + bias;
        asm volatile("s_waitcnt lgkmcnt(0)" ::: "memory");
    }
    constexpr int I_IN = 16 * 248, I_A = 16 * 32, I_B = 8 * 32, I_O = 16 * 32, I_GU = 16 * 176, I_D = 44 * 32;
    constexpr int NITEMS = I_IN + I_A + I_B + I_O + I_GU + I_D;
    for (int it = gw; it < NITEMS; it += NGW) {
        int r = it;
        if (r < I_IN) { const int nb = r % 248, kb = r / 248; p0_transpose_item(a.w_in, 1024, INW, (bf16*)(ws + WS_WIN), 32 * nb, win_src(32 * nb), kb, scr, lane); continue; } r -= I_IN;
        if (r < I_A) { const int nb = r % 32, kb = r / 32; p0_transpose_item(a.w_a, 1024, 1024, (bf16*)(ws + WS_WA), 32 * nb, 32 * nb, kb, scr, lane); continue; } r -= I_A;
        if (r < I_B) { const int nb = r % 32, kb = r / 32; p0_transpose_item(a.w_b, 512, 1024, (bf16*)(ws + WS_WB), 32 * nb, 32 * nb, kb, scr, lane); continue; } r -= I_B;
        if (r < I_O) { const int nb = r % 32, kb = r / 32; p0_transpose_item(a.w_o, 1024, 1024, (bf16*)(ws + WS_WO), 32 * nb, 32 * nb, kb, scr, lane); continue; } r -= I_O;
        if (r < I_GU) { const int nb = r % 176, kb = r / 176; p0_transpose_item(a.w_gu, 1024, 2 * DFF, (bf16*)(ws + WS_WGU), 32 * nb, wgu_src(32 * nb), kb, scr, lane); continue; } r -= I_GU;
        { const int nb = r % 32, kb = r / 32; p0_transpose_item(a.w_d, DFF, 1024, (bf16*)(ws + WS_WD), 32 * nb, 32 * nb, kb, scr, lane); }
    }
    {
        f32x2v* rope = (f32x2v*)(ws + WS_ROPE);
        const int gt = blockIdx.x * (NWAVES * 64) + threadIdx.x, NT = gridDim.x * NWAVES * 64;
        for (int idx = gt; idx < M * 32; idx += NT) {
            const int row = idx >> 5, i = idx & 31;
            const float inv = exp2f(-(float)i * (13.287712379549449f / 32.0f));
            const float ang = (float)a.pos[row] * inv;
            double rev = (double)ang * 0.15915494309189535; rev -= floor(rev);
            const float fr = (float)rev;
            rope[idx] = (f32x2v){__builtin_amdgcn_cosf(fr), __builtin_amdgcn_sinf(fr)};
        }
    }
}

__device__ __forceinline__ void phase1(const Args& a, LAS unsigned char* lds, int wave, int lane) {
    asm volatile("" : "+v"(lane));
    unsigned char* ws = a.ws; const float* modp = (const float*)(ws + WS_MODP); float* mod = (float*)(ws + WS_MOD);
    const int tid = threadIdx.x;
    for (int idx = blockIdx.x * 512 + tid; idx < 16 * MODW; idx += gridDim.x * 512) {
        float s = 0.f;
#pragma unroll
        for (int kc = 0; kc < 8; ++kc) s += modp[(size_t)kc * 16 * MODW + idx];
        mod[idx] = s;
    }
    LAS float* ss = (LAS float*)lds;
    bf16* U = (bf16*)(ws + WS_U);
    for (int chunk = blockIdx.x; chunk < M / 128; chunk += gridDim.x) {
        const int b = chunk / (T / 128);
        __syncthreads();
        for (int idx = tid; idx < 2048; idx += 512) {
            float s = 0.f;
#pragma unroll
            for (int kc = 0; kc < 8; ++kc) s += modp[(size_t)kc * 16 * MODW + (size_t)b * MODW + idx];
            ss[idx] = s;
        }
        __syncthreads();
        for (int rr = wave; rr < 128; rr += NWAVES) {
            const int row = chunk * 128 + rr;
            const f32x4* xr = (const f32x4*)(a.x + (size_t)row * D) + lane;
            unsigned long long* o8 = (unsigned long long*)(U + (size_t)row * D) + lane;
#pragma unroll
            for (int j = 0; j < 4; ++j) {
                const f32x4 v = xr[64 * j]; const int col = 4 * lane + 256 * j;
                const f32x4 sh = *(const LAS f32x4*)(ss + col), sc = *(const LAS f32x4*)(ss + 1024 + col);
                const f32x4 uu = v * (sc + 1.0f) + sh;
                o8[64 * j] = (unsigned long long)pk2(uu[0], uu[1]) | ((unsigned long long)pk2(uu[2], uu[3]) << 32);
            }
        }
    }
    __syncthreads();
}

__device__ __forceinline__ int crow(int r, int hi) { return (r & 3) + 8 * (r >> 2) + 4 * hi; }
__device__ __forceinline__ void attn_phase(const Args& a, LAS unsigned char* lds, int wave, int lane) {
    asm volatile("" : "+v"(lane));
    unsigned char* ws = a.ws;
    const int r32 = lane & 31, hi = lane >> 5;
    LAS unsigned char* vt = lds + wave * 4096;
    const unsigned vaddr = (unsigned)(uintptr_t)vt + (4 * hi + ((lane & 15) >> 2)) * 64 + ((lane >> 4) & 1) * 32 + (lane & 3) * 8;
    const int vkey = lane >> 3, vch = lane & 7;
    LAS unsigned char* vwr = vt + (vch >> 2) * 2048 + vkey * 64 + (vch & 3) * 16;
    for (int bi = blockIdx.x; bi < 5120; bi += gridDim.x) {
        const int it = bi * 8 + wave;
        const bf16 *Q, *K, *V; bf16* O; int qp, kp, r, res, b, qs, nback; float sink2 = 0.f; bool has_sink; float* lse = nullptr;
        if (it < 16384) {
            const int g = it & 7; qs = (it >> 3) & 63; const int kvh = (it >> 9) & 1; b = it >> 10; r = 1; res = 0;
            const int hq = kvh * 8 + g;
            Q = (const bf16*)(ws + WS_QA) + hq * 64; qp = 1024; K = (const bf16*)(ws + WS_KVA) + kvh * 64; V = K + 128; kp = 256; O = (bf16*)(ws + WS_QA) + hq * 64;
            nback = 127; has_sink = true; sink2 = a.sinks[hq] * LOG2E;
        } else {
            const int it2 = it - 16384, grp = it2 >> 13, it3 = it2 & 8191, j = it3 & 7; b = it3 >> 9;
            if (grp == 0) { qs = (it3 >> 3) & 63; r = 1; res = 0; }
            else if (grp == 1) { qs = (it3 >> 3) & 15; res = (it3 >> 7) & 3; r = 4; }
            else { qs = (it3 >> 3) & 3; res = (it3 >> 5) & 15; r = 16; }
            const int h = grp * 8 + j;
            Q = (const bf16*)(ws + WS_QB) + h * 64; qp = 1536; K = (const bf16*)(ws + WS_KB) + h * 64; V = (const bf16*)(ws + WS_VB) + h * 64; kp = 1536; O = (bf16*)(ws + WS_QB) + h * 64;
            nback = 128; has_sink = false; lse = (float*)(ws + WS_LSE) + (size_t)grp * M * 8 + j;
        }
        const int q0 = qs * 32; const int tokbase = b * T + res;
        const int jstart = q0 >= 128 ? 0 : ((128 - q0) >> 5);
        const size_t qtok = (size_t)(tokbase + r * (q0 + r32));
        bf16x8 qf[4];
#pragma unroll
        for (int d0 = 0; d0 < 4; ++d0) qf[d0] = *(const bf16x8*)(Q + qtok * qp + d0 * 16 + hi * 8);
        f32x16 S[5];
#pragma unroll
        for (int j = 0; j < 5; ++j) {
            if (j >= jstart) {
                const int kt0 = q0 - 128 + 32 * j;
                const bf16* kr = K + (size_t)(tokbase + r * (kt0 + r32)) * kp + hi * 8;
                bf16x8 kf[4];
#pragma unroll
                for (int d0 = 0; d0 < 4; ++d0) kf[d0] = *(const bf16x8*)(kr + d0 * 16);
                f32x16 s = {};
#pragma unroll
                for (int d0 = 0; d0 < 4; ++d0) s = __builtin_amdgcn_mfma_f32_32x32x16_bf16(kf[d0], qf[d0], s, 0, 0, 0);
                S[j] = s;
            } else S[j] = f32x16{};
        }
        if (jstart == 0) {
#pragma unroll
            for (int rr = 0; rr < 16; ++rr) { const int dist = 128 + r32 - crow(rr, hi); if (dist > nback) S[0][rr] = -INFINITY; }
        }
#pragma unroll
        for (int rr = 0; rr < 16; ++rr) { if (r32 - crow(rr, hi) < 0) S[4][rr] = -INFINITY; }
        float mx = -INFINITY;
#pragma unroll
        for (int j = 0; j < 5; ++j) if (j >= jstart) {
#pragma unroll
            for (int rr = 0; rr < 16; ++rr) mx = fmaxf(mx, S[j][rr]);
        }
        mx = fmaxf(mx, __shfl_xor(mx, 32));
        if (has_sink) mx = fmaxf(mx, sink2);
        float ls = 0.f;
#pragma unroll
        for (int j = 0; j < 5; ++j) if (j >= jstart) {
#pragma unroll
            for (int rr = 0; rr < 16; ++rr) { const float p = __builtin_amdgcn_exp2f(S[j][rr] - mx); S[j][rr] = p; ls += p; }
        }
        ls += __shfl_xor(ls, 32);
        if (has_sink) ls += __builtin_amdgcn_exp2f(sink2 - mx);
        f32x16 OT[2]; OT[0] = f32x16{}; OT[1] = f32x16{};
#pragma unroll
        for (int j = 0; j < 5; ++j) if (j >= jstart) {
            const int kt0 = q0 - 128 + 32 * j;
            u32x4 vv[4];
#pragma unroll
            for (int i4 = 0; i4 < 4; ++i4) vv[i4] = *(const u32x4*)(V + (size_t)(tokbase + r * (kt0 + vkey + 8 * i4)) * kp + vch * 8);
#pragma unroll
            for (int i4 = 0; i4 < 4; ++i4) *(LAS u32x4*)(vwr + i4 * 512) = vv[i4];
            u32x4 pw[2];
#pragma unroll
            for (int kh = 0; kh < 2; ++kh) { pw[kh].x = pk2(S[j][8 * kh + 0], S[j][8 * kh + 1]); pw[kh].y = pk2(S[j][8 * kh + 2], S[j][8 * kh + 3]); pw[kh].z = pk2(S[j][8 * kh + 4], S[j][8 * kh + 5]); pw[kh].w = pk2(S[j][8 * kh + 6], S[j][8 * kh + 7]); }
            s16x4 lo[2][2], hh[2][2];
#define TRRD(dst, off) asm volatile("ds_read_b64_tr_b16 %0, %1 offset:" #off : "=&v"(dst) : "v"(vaddr) : "memory")
            TRRD(lo[0][0], 0);    TRRD(hh[0][0], 512);  TRRD(lo[0][1], 1024); TRRD(hh[0][1], 1536);
            TRRD(lo[1][0], 2048); TRRD(hh[1][0], 2560); TRRD(lo[1][1], 3072); TRRD(hh[1][1], 3584);
#undef TRRD
            asm volatile("s_waitcnt lgkmcnt(0)" : "+v"(lo[0][0]), "+v"(lo[0][1]), "+v"(lo[1][0]), "+v"(lo[1][1]), "+v"(hh[0][0]), "+v"(hh[0][1]), "+v"(hh[1][0]), "+v"(hh[1][1]) :: "memory");
#pragma unroll
            for (int db = 0; db < 2; ++db)
#pragma unroll
                for (int kh = 0; kh < 2; ++kh) {
                    const bf16x8 af = (bf16x8){lo[db][kh][0], lo[db][kh][1], lo[db][kh][2], lo[db][kh][3], hh[db][kh][0], hh[db][kh][1], hh[db][kh][2], hh[db][kh][3]};
                    OT[db] = __builtin_amdgcn_mfma_f32_32x32x16_bf16(af, __builtin_bit_cast(bf16x8, pw[kh]), OT[db], 0, 0, 0);
                }
        }
        const float inv_l = 1.0f / ls;
        bf16* op = O + qtok * qp;
#pragma unroll
        for (int db = 0; db < 2; ++db)
#pragma unroll
            for (int rg = 0; rg < 4; ++rg) {
                u32x2 w; w.x = pk2(OT[db][4 * rg + 0] * inv_l, OT[db][4 * rg + 1] * inv_l); w.y = pk2(OT[db][4 * rg + 2] * inv_l, OT[db][4 * rg + 3] * inv_l);
                *(u32x2*)(op + 32 * db + 8 * rg + 4 * hi) = w;
            }
        if (lse != nullptr && hi == 0) lse[qtok * 8] = mx + __builtin_amdgcn_logf(ls);
    }
}

__device__ __forceinline__ void merge_pass(const Args& a, int wave, int lane) {
    asm volatile("" : "+v"(lane));
    unsigned char* ws = a.ws; const bf16* OG = (const bf16*)(ws + WS_QB); const float* LSE = (const float*)(ws + WS_LSE); bf16* OB = (bf16*)(ws + WS_OB);
    const int gw = blockIdx.x * NWAVES + wave, NGW = gridDim.x * NWAVES; const int j = lane >> 3, ch = lane & 7;
    for (int row = gw; row < M; row += NGW) {
        const float l0 = LSE[(size_t)row * 8 + j], l1 = LSE[(size_t)M * 8 + (size_t)row * 8 + j], l2 = LSE[(size_t)2 * M * 8 + (size_t)row * 8 + j];
        const float mx = fmaxf(l0, fmaxf(l1, l2));
        float e0 = __builtin_amdgcn_exp2f(l0 - mx), e1 = __builtin_amdgcn_exp2f(l1 - mx), e2 = __builtin_amdgcn_exp2f(l2 - mx);
        const float inv = 1.0f / (e0 + e1 + e2); e0 *= inv; e1 *= inv; e2 *= inv;
        const bf16* p = OG + (size_t)row * 1536 + j * 64 + ch * 8;
        const u32x4 a0 = *(const u32x4*)(p), a1 = *(const u32x4*)(p + 512), a2 = *(const u32x4*)(p + 1024);
        u32x4 o;
        o.x = pk2(e0 * bflo(a0.x) + e1 * bflo(a1.x) + e2 * bflo(a2.x), e0 * bfhi(a0.x) + e1 * bfhi(a1.x) + e2 * bfhi(a2.x));
        o.y = pk2(e0 * bflo(a0.y) + e1 * bflo(a1.y) + e2 * bflo(a2.y), e0 * bfhi(a0.y) + e1 * bfhi(a1.y) + e2 * bfhi(a2.y));
        o.z = pk2(e0 * bflo(a0.z) + e1 * bflo(a1.z) + e2 * bflo(a2.z), e0 * bfhi(a0.z) + e1 * bfhi(a1.z) + e2 * bfhi(a2.z));
        o.w = pk2(e0 * bflo(a0.w) + e1 * bflo(a1.w) + e2 * bflo(a2.w), e0 * bfhi(a0.w) + e1 * bfhi(a1.w) + e2 * bfhi(a2.w));
        *(u32x4*)(OB + (size_t)row * 512 + j * 64 + ch * 8) = o;
    }
}

template <bool FIRST> __device__ __forceinline__ void ln_pass(const Args& a, int wave, int lane) {
    asm volatile("" : "+v"(lane));
    unsigned char* ws = a.ws;
    const f32x2v* st = (const f32x2v*)(ws + (FIRST ? WS_ST1 : WS_ST2));
    const float* zin = FIRST ? (const float*)(ws + WS_Z) : a.out;
    const float* lg = FIRST ? a.ln1g : a.ln2g; const float* lb = FIRST ? a.ln1b : a.ln2b;
    const float* mod = (const float*)(ws + WS_MOD);
    const int gw = blockIdx.x * NWAVES + wave, NGW = gridDim.x * NWAVES;
    for (int row = gw; row < M; row += NGW) {
        f32x2v p = st[(size_t)row * 16 + (lane & 15)];
        float s = p.x, q = p.y;
#pragma unroll
        for (int o = 1; o < 16; o <<= 1) { s += __shfl_xor(s, o); q += __shfl_xor(q, o); }
        const float mean = s * (1.0f / D); const float var = fmaxf(q * (1.0f / D) - mean * mean, 0.f); const float rstd = 1.0f / sqrtf(var + LN_EPS);
        if (FIRST && lane == 0) ((f32x2v*)(ws + WS_RSTAT))[row] = (f32x2v){mean, rstd};
        const int b = row / T;
        const f32x4* zr = (const f32x4*)(zin + (size_t)row * D) + lane;
#pragma unroll
        for (int j = 0; j < 4; ++j) {
            const int col = 4 * lane + 256 * j;
            const f32x4 z = zr[64 * j]; const f32x4 g = *(const f32x4*)(lg + col), bb = *(const f32x4*)(lb + col);
            const f32x4 x1 = (z - mean) * rstd * g + bb;
            if (FIRST) {
                const f32x4 sh = *(const f32x4*)(mod + (size_t)b * MODW + 3 * D + col), sc = *(const f32x4*)(mod + (size_t)b * MODW + 4 * D + col);
                const f32x4 uu = x1 * (sc + 1.0f) + sh;
                ((unsigned long long*)((bf16*)(ws + WS_U) + (size_t)row * D))[lane + 64 * j] = (unsigned long long)pk2(uu[0], uu[1]) | ((unsigned long long)pk2(uu[2], uu[3]) << 32);
            } else {
                ((f32x4*)(a.out + (size_t)row * D))[lane + 64 * j] = x1;
            }
        }
    }
}

#ifndef PH_HI
#define PH_HI 99
#endif
__global__ void __launch_bounds__(NWAVES * 64, 2) mega_fwd(Args a) {
    extern __shared__ __attribute__((aligned(16))) unsigned char lds_raw[];
    LAS unsigned char* lds = (LAS unsigned char*)lds_raw;
    cg::grid_group grid = cg::this_grid();
    const int tid = threadIdx.x, lane = tid & 63, wave = __builtin_amdgcn_readfirstlane(tid >> 6);
    unsigned char* ws = a.ws;
    bf16* GA = (bf16*)a.out; bf16* GB = GA + (size_t)M * 1024;
    const int G = gridDim.x, c = blockIdx.x;

    phase0(a, lds, wave, lane);
    grid.sync();
    phase1(a, lds, wave, lane);
    grid.sync();
    {
        pg8::Gemm g{(const bf16*)(ws + WS_U), (const bf16*)(ws + WS_WIN), M, INW, 1024}; pg8::StaticOrder S; S.init(M, INW, G, c);
        pg8::EpiInProj E{ws, GA, (const f32x4*)(ws + WS_ROPE)};
        pg8::gemm_phase<pg8::EpiInProj, pg8::StaticOrder, true, true>(lds, g, S, E);
    }
    grid.sync();
    attn_phase(a, lds, wave, lane);
    grid.sync();
    merge_pass(a, wave, lane);
    {
        pg8::Gemm g{(const bf16*)(ws + WS_QA), (const bf16*)(ws + WS_WA), M, 1024, 1024}; pg8::StaticOrder S; S.init(M, 1024, G, c);
        pg8::EpiGate<false> E{(bf16*)(ws + WS_YAS), GA, nullptr};
        pg8::gemm_phase<pg8::EpiGate<false>, pg8::StaticOrder, true, true>(lds, g, S, E);
    }
    grid.sync();
    {
        pg8::Gemm g{(const bf16*)(ws + WS_OB), (const bf16*)(ws + WS_WB), M, 1024, 512}; pg8::StaticOrder S; S.init(M, 1024, G, c);
        pg8::EpiGate<true> E{(bf16*)(ws + WS_MERGED), GB, (const bf16*)(ws + WS_YAS)};
        pg8::gemm_phase<pg8::EpiGate<true>, pg8::StaticOrder, true, true>(lds, g, S, E);
    }
    grid.sync();
    {
        pg8::Gemm g{(const bf16*)(ws + WS_MERGED), (const bf16*)(ws + WS_WO), M, 1024, 1024}; pg8::StaticOrder S; S.init(M, 1024, G, c);
        pg8::EpiRes<false> E{a.x, (float*)(ws + WS_Z), (const float*)(ws + WS_MOD) + 2 * D, (f32x2v*)(ws + WS_ST1), nullptr, nullptr, nullptr};
        pg8::gemm_phase<pg8::EpiRes<false>, pg8::StaticOrder, true, true>(lds, g, S, E);
    }
    grid.sync();
    ln_pass<true>(a, wave, lane);
    grid.sync();
    {
        pg8::Gemm g{(const bf16*)(ws + WS_U), (const bf16*)(ws + WS_WGU), M, 2 * DFF, 1024}; pg8::StaticOrder S; S.init(M, 2 * DFF, G, c);
        pg8::EpiSwiGLU E{(bf16*)(ws + WS_H)};
        pg8::gemm_phase<pg8::EpiSwiGLU, pg8::StaticOrder, true, true>(lds, g, S, E);
    }
    grid.sync();
    {
        pg8::Gemm g{(const bf16*)(ws + WS_H), (const bf16*)(ws + WS_WD), M, 1024, DFF}; pg8::StaticOrder S; S.init(M, 1024, G, c);
        pg8::EpiRes<true> E{(const float*)(ws + WS_Z), a.out, (const float*)(ws + WS_MOD) + 5 * D, (f32x2v*)(ws + WS_ST2), (const f32x2v*)(ws + WS_RSTAT), a.ln1g, a.ln1b};
        pg8::gemm_phase<pg8::EpiRes<true>, pg8::StaticOrder, true, true>(lds, g, S, E);
    }
    grid.sync();
    ln_pass<false>(a, wave, lane);
}

extern "C" void kernel_launch(void* const* d_in, const int* in_sizes, int n_in, void* d_out, int out_size, void* d_ws, size_t ws_size, hipStream_t stream) {
    static int grid = 0;
    if (grid == 0) {
        if (n_in != 16 || in_sizes[0] != M * D || out_size != M * D || ws_size < WS_END) {
            fprintf(stderr, "kernel_launch: unexpected shapes: n_in %d in0 %d out %d ws %zu (need %zu)\n", n_in, n_in > 0 ? in_sizes[0] : -1, out_size, ws_size, (size_t)WS_END); grid = -1; return; }
        int dev = 0, cus = 0, per_cu = 0;
        hipGetDevice(&dev); hipDeviceGetAttribute(&cus, hipDeviceAttributeMultiprocessorCount, dev);
        if (hipFuncSetAttribute((const void*)mega_fwd, hipFuncAttributeMaxDynamicSharedMemorySize, LDS_BYTES) != hipSuccess) { fprintf(stderr, "kernel_launch: hipFuncSetAttribute failed\n"); grid = -1; return; }
        if (hipOccupancyMaxActiveBlocksPerMultiprocessor(&per_cu, (const void*)mega_fwd, NWAVES * 64, LDS_BYTES) != hipSuccess || per_cu < 1) { fprintf(stderr, "kernel_launch: occupancy query failed (%d)\n", per_cu); per_cu = 1; }
        (void)hipGetLastError();
        grid = cus * (per_cu > 1 ? 1 : per_cu);
        if (grid < 8) grid = 8;
    }
    if (grid < 0) return;
    Args a{};
    a.x = (const float*)d_in[0]; a.c = (const float*)d_in[1]; a.pos = (const int*)d_in[2]; a.w_ada = (const float*)d_in[3]; a.b_ada = (const float*)d_in[4];
    a.w_in = (const float*)d_in[5]; a.sinks = (const float*)d_in[6]; a.w_a = (const float*)d_in[7]; a.w_b = (const float*)d_in[8]; a.w_o = (const float*)d_in[9];
    a.ln1g = (const float*)d_in[10]; a.ln1b = (const float*)d_in[11]; a.w_gu = (const float*)d_in[12]; a.w_d = (const float*)d_in[13]; a.ln2g = (const float*)d_in[14]; a.ln2b = (const float*)d_in[15];
    a.out = (float*)d_out; a.ws = (unsigned char*)d_ws;
    void* args[] = {&a};
    hipError_t e = hipLaunchCooperativeKernel((const void*)mega_fwd, dim3(grid), dim3(NWAVES * 64), args, LDS_BYTES, stream);
    if (e != hipSuccess) fprintf(stderr, "kernel_launch: cooperative launch failed: %s (grid %d)\n", hipGetErrorString(e), grid);
}
```

```cpp
#include <hip/hip_runtime.h>
#include <hip/hip_cooperative_groups.h>
#include <cstdio>
#include <cstdint>
namespace cg = cooperative_groups;
namespace pg8 {
#define PG8_LAS __attribute__((address_space(3)))
typedef unsigned short bf16_t;
typedef short bf16x8 __attribute__((ext_vector_type(8)));
typedef float f32x4 __attribute__((ext_vector_type(4)));
typedef unsigned u32x4 __attribute__((ext_vector_type(4)));
constexpr int BM = 256, BK = 64, HALF = 128, HTB = HALF * BK * 2  , STAGE_BYTES = 8 * HTB, NXCD = 8, WGM = 8;

__host__ __device__ __forceinline__ int lds_byte(int r, int c) { const int st = (r >> 4) * 2 + (c >> 5), rr = r & 15, cc = c & 31, ob = rr * 64 + cc * 2; return st * 1024 + (ob ^ (((ob >> 9) & 1) << 5)); }
__host__ __device__ __forceinline__ void stage_rc(int b, int& R, int& C) { const int st = b / 1024, sb = b % 1024, swz = sb ^ (((sb >> 9) & 1) << 5); R = (st >> 1) * 16 + swz / 64; C = (st & 1) * 32 + (swz % 64) / 2; }
__host__ __device__ __forceinline__ int perm32(int rho) { const int n = rho >> 4, i = rho & 15; return 8 * (i >> 2) + 4 * n + (i & 3); }

struct Unit { int pm, pn; };
struct Gemm { const bf16_t* A; const bf16_t* Bt; int M, N, K; };

struct StaticOrder {
    int nM, nN, nwg, G, c;
    __host__ __device__ void init(int M, int N, int G_, int c_) { nM = M / BM; nN = N / BM; nwg = nM * nN; G = G_; c = c_; }
    __host__ __device__ bool next(int i, Unit& u) const {
        const long L = (long)i * G + c; if (L >= nwg) return false;
        int wgid = (int)L; { const int q = nwg / NXCD, r = nwg % NXCD, xcd = wgid % NXCD, off = wgid / NXCD; wgid = (xcd < r ? xcd * (q + 1) : r * (q + 1) + (xcd - r) * q) + off; }
        const int nig = WGM * nN, gid = wgid / nig, fm = gid * WGM, gsz = (nM - fm) < WGM ? (nM - fm) : WGM;
        u.pm = fm + ((wgid % nig) % gsz); u.pn = (wgid % nig) / gsz; return true;
    }
    __device__ __forceinline__ void a_ready(const Unit&) const {}
    __device__ __forceinline__ void done(const Unit&) const {}
};

__device__ __forceinline__ unsigned cvt_pk_bf16(float lo, float hi) { unsigned r; asm volatile("v_cvt_pk_bf16_f32 %0, %1, %2" : "=v"(r) : "v"(lo), "v"(hi)); return r; }
typedef float f32x2 __attribute__((ext_vector_type(2)));
template <class Epi, class Sched, bool ALIGN_EPI = false, bool SP2 = false>
__device__ __forceinline__ void gemm_phase(PG8_LAS unsigned char* lds, const Gemm g, const Sched& S, const Epi& E) {
    const int tid = threadIdx.x, wid = __builtin_amdgcn_readfirstlane(tid >> 6), lane = tid & 63, wr = wid >> 2, wc = wid & 3, fr = lane & 15, fq = lane >> 4;
    const int K = g.K, nt = K / BK;
    unsigned voffA[2], voffB[2];
#pragma unroll
    for (int i = 0; i < 2; ++i) { int R, C; stage_rc(tid * 16 + i * 8192, R, C); const int Rb = Epi::PERM ? ((R & ~31) + perm32(R & 31)) : R;
        voffA[i] = (unsigned)(R * K + C) * 2u; voffB[i] = (unsigned)(Rb * K + C) * 2u; }
    const size_t kstep = (size_t)(BK * 2);
    const size_t hstep = (size_t)HALF * K * 2;
    const size_t tstep = 2 * hstep;
    const unsigned ldsw = (unsigned)wid * 1024u;
    const int aoff = lds_byte(wr * 64 + fr, fq * 8), boff = lds_byte(wc * 32 + fr, fq * 8);
#define PG8_SA(b, h) (((b) * 2 + (h)) * HTB)
#define PG8_SB(b, h) ((4 + (b) * 2 + (h)) * HTB)
#define PG8_STAGE(bufoff, gbase, voff) do { _Pragma("unroll") for (int _i = 0; _i < 2; ++_i) \
        __builtin_amdgcn_global_load_lds((const unsigned*)((const char*)(gbase) + (voff)[_i]), (PG8_LAS unsigned*)(lds + (bufoff) + ldsw + _i * 8192), 16, 0, 0); } while (0)
#define PG8_LDA(dst, b, h) do { _Pragma("unroll") for (int m = 0; m < 4; ++m) _Pragma("unroll") for (int k = 0; k < 2; ++k) dst[m][k] = *(const PG8_LAS bf16x8*)(lds + PG8_SA(b, h) + aoff + m * 2048 + k * 1024); } while (0)
#define PG8_LDB(dst, b, h) do { _Pragma("unroll") for (int n = 0; n < 2; ++n) _Pragma("unroll") for (int k = 0; k < 2; ++k) dst[n][k] = *(const PG8_LAS bf16x8*)(lds + PG8_SB(b, h) + boff + n * 2048 + k * 1024); } while (0)
#define PG8_MMA(ai, bj, At, Bt) do { __builtin_amdgcn_s_setprio(1); _Pragma("unroll") for (int m = 0; m < 4; ++m) _Pragma("unroll") for (int n = 0; n < 2; ++n) _Pragma("unroll") for (int k = 0; k < 2; ++k) \
        acc[ai][bj][m][n] = __builtin_amdgcn_mfma_f32_16x16x32_bf16(Bt[n][k], At[m][k], acc[ai][bj][m][n], 0, 0, 0); __builtin_amdgcn_s_setprio(0); } while (0)
#define PG8_WAIT_V(n) asm volatile("s_waitcnt vmcnt(" #n ")" ::: "memory")
#define PG8_WAIT_L(n) asm volatile("s_waitcnt lgkmcnt(" #n ")" ::: "memory")
#define PG8_BAR __builtin_amdgcn_s_barrier()
#define PG8_SCHED __builtin_amdgcn_sched_barrier(0)
    Unit cur, nxt; int ui = 0;
    if (!S.next(0, cur)) return;
    f32x4 acc[2][2][4][2];
#pragma unroll
    for (int a = 0; a < 2; ++a)
#pragma unroll
        for (int b = 0; b < 2; ++b)
#pragma unroll
            for (int m = 0; m < 4; ++m)
#pragma unroll
                for (int n = 0; n < 2; ++n) acc[a][b][m][n] = (f32x4){0.f, 0.f, 0.f, 0.f};
    bf16x8 At[4][2], B0[2][2], B1[2][2];
    const char* cA = (const char*)g.A + (size_t)cur.pm * tstep; const char* cB = (const char*)g.Bt + (size_t)cur.pn * tstep;
    S.a_ready(cur);
    if constexpr (SP2) {
        PG8_STAGE(PG8_SB(0, 0), cB, voffB); PG8_STAGE(PG8_SB(0, 1), cB + hstep, voffB); PG8_STAGE(PG8_SA(0, 0), cA, voffA); PG8_STAGE(PG8_SA(0, 1), cA + hstep, voffA);
        if (wr == 1) PG8_BAR;
        PG8_WAIT_V(2); PG8_BAR;
        PG8_STAGE(PG8_SB(1, 0), cB + kstep, voffB); PG8_STAGE(PG8_SA(1, 0), cA + kstep, voffA); PG8_STAGE(PG8_SB(1, 1), cB + hstep + kstep, voffB);
        PG8_WAIT_V(6); PG8_BAR;
    } else {
        PG8_STAGE(PG8_SB(0, 0), cB, voffB); PG8_STAGE(PG8_SA(0, 0), cA, voffA); PG8_STAGE(PG8_SB(0, 1), cB + hstep, voffB); PG8_STAGE(PG8_SA(0, 1), cA + hstep, voffA);
        if (wr == 1) PG8_BAR;
        PG8_WAIT_V(4); PG8_BAR;
        PG8_STAGE(PG8_SB(1, 0), cB + kstep, voffB); PG8_STAGE(PG8_SA(1, 0), cA + kstep, voffA); PG8_STAGE(PG8_SB(1, 1), cB + hstep + kstep, voffB);
        PG8_WAIT_V(6); PG8_BAR;
    }
    for (;;) {
        const bool has_next = S.next(ui + 1, nxt);
        const char* nA = has_next ? (const char*)g.A + (size_t)nxt.pm * tstep : cA; const char* nB = has_next ? (const char*)g.Bt + (size_t)nxt.pn * tstep : cB;
        for (int t = 0; t < nt; t += 2) {
            const bool last = (t == nt - 2);
            const char* a1 = cA + (size_t)(t + 1) * kstep;
            const char* a2 = last ? nA : cA + (size_t)(t + 2) * kstep; const char* b2 = last ? nB : cB + (size_t)(t + 2) * kstep;
            const char* a3 = a2 + kstep; const char* b3 = b2 + kstep;
            if (last && has_next) S.a_ready(nxt);
            if constexpr (SP2) {
            PG8_LDB(B0, 0, 0); PG8_LDB(B1, 0, 1); PG8_SCHED; PG8_LDA(At, 0, 0); PG8_STAGE(PG8_SA(1, 1), a1 + hstep, voffA);
            PG8_WAIT_V(8); PG8_WAIT_L(0); PG8_BAR; PG8_MMA(0, 0, At, B0); PG8_MMA(0, 1, At, B1); PG8_BAR; PG8_SCHED;
            PG8_LDA(At, 0, 1); PG8_STAGE(PG8_SB(0, 0), b2, voffB); PG8_STAGE(PG8_SB(0, 1), b2 + hstep, voffB); PG8_STAGE(PG8_SA(0, 0), a2, voffA);
            PG8_WAIT_V(8); PG8_WAIT_L(0); PG8_BAR; PG8_MMA(1, 0, At, B0); PG8_MMA(1, 1, At, B1); PG8_BAR; PG8_SCHED;
            PG8_LDB(B0, 1, 0); PG8_LDB(B1, 1, 1); PG8_SCHED; PG8_LDA(At, 1, 0); PG8_STAGE(PG8_SA(0, 1), a2 + hstep, voffA);
            PG8_WAIT_V(8); PG8_WAIT_L(0); PG8_BAR; PG8_MMA(0, 0, At, B0); PG8_MMA(0, 1, At, B1); PG8_BAR; PG8_SCHED;
            PG8_LDA(At, 1, 1); PG8_STAGE(PG8_SB(1, 0), b3, voffB); PG8_STAGE(PG8_SB(1, 1), b3 + hstep, voffB); PG8_STAGE(PG8_SA(1, 0), a3, voffA);
            PG8_WAIT_V(8); PG8_WAIT_L(0); PG8_BAR; PG8_MMA(1, 0, At, B0); PG8_MMA(1, 1, At, B1); PG8_BAR; PG8_SCHED;
            } else {
            PG8_LDB(B0, 0, 0); PG8_SCHED; PG8_LDA(At, 0, 0); PG8_STAGE(PG8_SA(1, 1), a1 + hstep, voffA);
            PG8_WAIT_L(8); PG8_BAR; PG8_WAIT_L(0); PG8_MMA(0, 0, At, B0); PG8_BAR; PG8_SCHED;
            PG8_LDB(B1, 0, 1); PG8_STAGE(PG8_SB(0, 0), b2, voffB);
            PG8_BAR; PG8_WAIT_L(0); PG8_MMA(0, 1, At, B1); PG8_BAR;
            PG8_LDA(At, 0, 1); PG8_STAGE(PG8_SA(0, 0), a2, voffA);
            PG8_BAR; PG8_WAIT_L(0); PG8_MMA(1, 0, At, B0); PG8_BAR; PG8_SCHED;
            PG8_STAGE(PG8_SB(0, 1), b2 + hstep, voffB);
            PG8_WAIT_V(6); PG8_BAR; PG8_MMA(1, 1, At, B1); PG8_BAR;
            PG8_LDB(B0, 1, 0); PG8_SCHED; PG8_LDA(At, 1, 0); PG8_STAGE(PG8_SA(0, 1), a2 + hstep, voffA);
            PG8_WAIT_L(8); PG8_BAR; PG8_WAIT_L(0); PG8_MMA(0, 0, At, B0); PG8_BAR; PG8_SCHED;
            PG8_LDB(B1, 1, 1); PG8_STAGE(PG8_SB(1, 0), b3, voffB);
            PG8_BAR; PG8_WAIT_L(0); PG8_MMA(0, 1, At, B1); PG8_BAR;
            PG8_LDA(At, 1, 1); PG8_STAGE(PG8_SA(1, 0), a3, voffA);
            PG8_BAR; PG8_WAIT_L(0); PG8_MMA(1, 0, At, B0); PG8_BAR; PG8_SCHED;
            PG8_STAGE(PG8_SB(1, 1), b3 + hstep, voffB);
            PG8_WAIT_V(6); PG8_BAR; PG8_MMA(1, 1, At, B1); PG8_BAR;
            }
        }
        if constexpr (ALIGN_EPI) { if (wr == 0) PG8_BAR; }
        if constexpr (!Epi::AFTER_DRAIN) { E(acc, cur, wr, wc, fr, fq); S.done(cur); }
        if (!has_next) break;
#pragma unroll
        for (int a = 0; a < 2; ++a)
#pragma unroll
            for (int b = 0; b < 2; ++b)
#pragma unroll
                for (int m = 0; m < 4; ++m)
#pragma unroll
                    for (int n = 0; n < 2; ++n) acc[a][b][m][n] = (f32x4){0.f, 0.f, 0.f, 0.f};
        cur = nxt; cA = nA; cB = nB; ++ui;
        if constexpr (ALIGN_EPI) { if (wr == 1) PG8_BAR; }
    }
    PG8_WAIT_V(0);
    if constexpr (!ALIGN_EPI) { if (wr == 0) PG8_BAR; }
    PG8_BAR;
    if constexpr (Epi::AFTER_DRAIN) { E.fused(acc, cur, wr, wc, fr, fq, lds, wid, lane); S.done(cur); }
#undef PG8_SA
#undef PG8_SB
#undef PG8_STAGE
#undef PG8_LDA
#undef PG8_LDB
#undef PG8_MMA
#undef PG8_WAIT_V
#undef PG8_WAIT_L
#undef PG8_BAR
#undef PG8_SCHED
}
}

#define LAS __attribute__((address_space(3)))
typedef unsigned short bf16;
typedef float f32x4 __attribute__((ext_vector_type(4)));
typedef float f32x16 __attribute__((ext_vector_type(16)));
typedef unsigned u32x4 __attribute__((ext_vector_type(4)));
typedef unsigned u32x2 __attribute__((ext_vector_type(2)));
typedef short bf16x8 __attribute__((ext_vector_type(8)));
typedef short s16x4 __attribute__((ext_vector_type(4)));
typedef float f32x2v __attribute__((ext_vector_type(2)));

constexpr int NB = 16, T = 2048, D = 1024, M = NB * T;
constexpr int INW = 7936, DFF = 2816, MODW = 6 * D;
constexpr float LOG2E = 1.4426950408889634f;
constexpr float QSCALE = 0.125f * LOG2E;
constexpr float ALPHA = 1.189207115002721f;
constexpr float LN_EPS = 1e-5f;
constexpr int NWAVES = 8;

constexpr size_t MiB = 1u << 20;
constexpr size_t WS_MODP = 0, WS_MOD = 3 * MiB, WS_RSTAT = 3 * MiB + 512 * 1024, WS_LSE = 4 * MiB, WS_ROPE = 8 * MiB, WS_ST1 = 16 * MiB, WS_ST2 = 20 * MiB;
constexpr size_t WS_WIN = 24 * MiB, WS_WA = 40 * MiB, WS_WB = 42 * MiB, WS_WO = 43 * MiB, WS_WGU = 45 * MiB, WS_WD = 56 * MiB;
constexpr size_t WS_U = 64 * MiB, WS_QA = 128 * MiB, WS_KVA = 192 * MiB, WS_QB = 208 * MiB, WS_KB = 304 * MiB, WS_VB = 400 * MiB, WS_END = 496 * MiB;
constexpr size_t WS_OB = 64 * MiB, WS_YAS = 304 * MiB, WS_MERGED = 368 * MiB, WS_Z = 128 * MiB, WS_H = 256 * MiB;
constexpr size_t WS_BAR = 3 * MiB + 768 * 1024;
constexpr int LDS_MISC = 131072;
constexpr int LDS_BYTES = 135168;

struct Args {
    const float* x; const float* c; const int* pos; const float* w_ada; const float* b_ada; const float* w_in; const float* sinks;
    const float* w_a; const float* w_b; const float* w_o; const float* ln1g; const float* ln1b; const float* w_gu; const float* w_d;
    const float* ln2g; const float* ln2b; float* out; unsigned char* ws;
};

__device__ __forceinline__ unsigned pk2(float lo, float hi) { return pg8::cvt_pk_bf16(lo, hi); }
__device__ __forceinline__ float bflo(unsigned w) { return __uint_as_float(w << 16); }
__device__ __forceinline__ float bfhi(unsigned w) { return __uint_as_float(w & 0xffff0000u); }
__device__ __forceinline__ float sigmoidf_(float v) { return __builtin_amdgcn_rcpf(1.0f + __builtin_amdgcn_exp2f(-v * LOG2E)); }
__device__ __forceinline__ float wave_sum(float v) {
#pragma unroll
    for (int o = 1; o < 64; o <<= 1) v += __shfl_xor(v, o);
    return v;
}

namespace pg8 {
struct EpiInProj {
    static constexpr bool PERM = true, AFTER_DRAIN = false;
    unsigned char* ws; bf16_t* GA; const f32x4* rope;
    __device__ __forceinline__ void operator()(const f32x4 (&acc)[2][2][4][2], const Unit& u, int wr, int wc, int fr, int fq) const {
        const int pn = u.pn; const int row0 = u.pm * BM + wr * 64 + fr;
        if (pn <= 16) {
            size_t boff; int ldc, cb; float sc = 1.f; bool rope_on = true;
            if (pn < 4) { boff = WS_QA; ldc = 1024; cb = pn * 256; sc = QSCALE; }
            else if (pn == 4) { boff = WS_KVA; ldc = 256; cb = 0; rope_on = (wc < 2); }
            else if (pn < 11) { boff = WS_QB; ldc = 1536; cb = (pn - 5) * 256; sc = QSCALE; }
            else { boff = WS_KB; ldc = 1536; cb = (pn - 11) * 256; }
            bf16_t* base = (bf16_t*)(ws + boff);
            const int col = cb + 64 * wc + 8 * fq;
#pragma unroll
            for (int ai = 0; ai < 2; ++ai)
#pragma unroll
                for (int m = 0; m < 4; ++m) {
                    const int row = row0 + ai * HALF + m * 16;
                    f32x4 a0 = acc[ai][0][m][0], a1 = acc[ai][0][m][1], b0 = acc[ai][1][m][0], b1 = acc[ai][1][m][1];
                    f32x4 o0, o1, p0, p1;
                    if (rope_on) {
                        const f32x4* rp = rope + (size_t)row * 16 + 4 * fq;
                        const f32x4 c0 = rp[0], c1 = rp[1], c2 = rp[2], c3 = rp[3];
                        o0[0] = a0[0] * c0[0] - b0[0] * c0[1]; p0[0] = b0[0] * c0[0] + a0[0] * c0[1];
                        o0[1] = a0[1] * c0[2] - b0[1] * c0[3]; p0[1] = b0[1] * c0[2] + a0[1] * c0[3];
                        o0[2] = a0[2] * c1[0] - b0[2] * c1[1]; p0[2] = b0[2] * c1[0] + a0[2] * c1[1];
                        o0[3] = a0[3] * c1[2] - b0[3] * c1[3]; p0[3] = b0[3] * c1[2] + a0[3] * c1[3];
                        o1[0] = a1[0] * c2[0] - b1[0] * c2[1]; p1[0] = b1[0] * c2[0] + a1[0] * c2[1];
                        o1[1] = a1[1] * c2[2] - b1[1] * c2[3]; p1[1] = b1[1] * c2[2] + a1[1] * c2[3];
                        o1[2] = a1[2] * c3[0] - b1[2] * c3[1]; p1[2] = b1[2] * c3[0] + a1[2] * c3[1];
                        o1[3] = a1[3] * c3[2] - b1[3] * c3[3]; p1[3] = b1[3] * c3[2] + a1[3] * c3[3];
                    } else { o0 = a0; o1 = a1; p0 = b0; p1 = b1; }
                    o0 = o0 * sc; o1 = o1 * sc; p0 = p0 * sc; p1 = p1 * sc;
                    u32x4 w; w.x = cvt_pk_bf16(o0[0], o0[1]); w.y = cvt_pk_bf16(o0[2], o0[3]); w.z = cvt_pk_bf16(o1[0], o1[1]); w.w = cvt_pk_bf16(o1[2], o1[3]);
                    u32x4 v; v.x = cvt_pk_bf16(p0[0], p0[1]); v.y = cvt_pk_bf16(p0[2], p0[3]); v.z = cvt_pk_bf16(p1[0], p1[1]); v.w = cvt_pk_bf16(p1[2], p1[3]);
                    bf16_t* rowp = base + (size_t)row * ldc + col;
                    *(u32x4*)(rowp) = w; *(u32x4*)(rowp + 32) = v;
                }
        } else {
            bf16_t* base; int ldc, cb; const bool sig = (pn >= 23);
            if (pn < 23) { base = (bf16_t*)(ws + WS_VB); ldc = 1536; cb = (pn - 17) * 256; }
            else { base = GA + (pn < 27 ? (size_t)0 : (size_t)M * 1024); ldc = 1024; cb = ((pn - 23) & 3) * 256; }
            const int col = cb + 32 * wc + 8 * fq;
#pragma unroll
            for (int ai = 0; ai < 2; ++ai)
#pragma unroll
                for (int m = 0; m < 4; ++m) {
                    bf16_t* rowp = base + (size_t)(row0 + ai * HALF + m * 16) * ldc + col;
#pragma unroll
                    for (int bj = 0; bj < 2; ++bj) {
                        f32x4 v0 = acc[ai][bj][m][0], v1 = acc[ai][bj][m][1];
                        if (sig) {
#pragma unroll
                            for (int e = 0; e < 4; ++e) { v0[e] = sigmoidf_(v0[e]); v1[e] = sigmoidf_(v1[e]); }
                        }
                        u32x4 w; w.x = cvt_pk_bf16(v0[0], v0[1]); w.y = cvt_pk_bf16(v0[2], v0[3]); w.z = cvt_pk_bf16(v1[0], v1[1]); w.w = cvt_pk_bf16(v1[2], v1[3]);
                        *(u32x4*)(rowp + bj * HALF) = w;
                    }
                }
        }
    }
};
template <bool ADD> struct EpiGate {
    static constexpr bool PERM = true, AFTER_DRAIN = false;
    bf16_t* O; const bf16_t* G; const bf16_t* A;
    __device__ __forceinline__ void operator()(const f32x4 (&acc)[2][2][4][2], const Unit& u, int wr, int wc, int fr, int fq) const {
        const int row0 = u.pm * BM + wr * 64 + fr, col = u.pn * BM + wc * 32 + 8 * fq;
#pragma unroll
        for (int ai = 0; ai < 2; ++ai)
#pragma unroll
            for (int m = 0; m < 4; ++m) {
                const size_t off = (size_t)(row0 + ai * HALF + m * 16) * 1024 + col;
#pragma unroll
                for (int bj = 0; bj < 2; ++bj) {
                    const u32x4 g = *(const u32x4*)(G + off + bj * HALF);
                    f32x4 v0 = acc[ai][bj][m][0], v1 = acc[ai][bj][m][1];
                    v0[0] *= bflo(g.x); v0[1] *= bfhi(g.x); v0[2] *= bflo(g.y); v0[3] *= bfhi(g.y);
                    v1[0] *= bflo(g.z); v1[1] *= bfhi(g.z); v1[2] *= bflo(g.w); v1[3] *= bfhi(g.w);
                    if (ADD) { const u32x4 a = *(const u32x4*)(A + off + bj * HALF);
                        v0[0] += bflo(a.x); v0[1] += bfhi(a.x); v0[2] += bflo(a.y); v0[3] += bfhi(a.y);
                        v1[0] += bflo(a.z); v1[1] += bfhi(a.z); v1[2] += bflo(a.w); v1[3] += bfhi(a.w); }
                    u32x4 w; w.x = cvt_pk_bf16(v0[0], v0[1]); w.y = cvt_pk_bf16(v0[2], v0[3]); w.z = cvt_pk_bf16(v1[0], v1[1]); w.w = cvt_pk_bf16(v1[2], v1[3]);
                    *(u32x4*)(O + off + bj * HALF) = w;
                }
            }
    }
};
template <bool LNIN> struct EpiRes {
    static constexpr bool PERM = false, AFTER_DRAIN = false;
    const float* xin; float* zout; const float* gate  ; f32x2v* stats; const f32x2v* rstat; const float* lng; const float* lnb;
    __device__ __forceinline__ void operator()(const f32x4 (&acc)[2][2][4][2], const Unit& u, int wr, int wc, int fr, int fq) const {
        const int row0 = u.pm * BM + wr * 64 + fr, col0 = u.pn * BM + wc * 32 + 4 * fq;
        const float* gb = gate + (size_t)((u.pm * BM) / T) * MODW + col0;
        f32x4 gv[2][2], lg[2][2], lb[2][2];
#pragma unroll
        for (int bj = 0; bj < 2; ++bj)
#pragma unroll
            for (int n = 0; n < 2; ++n) { gv[bj][n] = *(const f32x4*)(gb + bj * HALF + n * 16) + 1.0f;
                if (LNIN) { lg[bj][n] = *(const f32x4*)(lng + col0 + bj * HALF + n * 16); lb[bj][n] = *(const f32x4*)(lnb + col0 + bj * HALF + n * 16); } }
#pragma unroll
        for (int ai = 0; ai < 2; ++ai)
#pragma unroll
            for (int m = 0; m < 4; ++m) {
                const int row = row0 + ai * HALF + m * 16; const size_t off = (size_t)row * 1024 + col0;
                f32x2v rs; if (LNIN) rs = rstat[row];
                float s = 0.f, q = 0.f;
#pragma unroll
                for (int bj = 0; bj < 2; ++bj)
#pragma unroll
                    for (int n = 0; n < 2; ++n) {
                        f32x4 xi = *(const f32x4*)(xin + off + bj * HALF + n * 16);
                        if (LNIN) xi = (xi - rs.x) * rs.y * lg[bj][n] + lb[bj][n];
                        const f32x4 z = xi * ALPHA + gv[bj][n] * acc[ai][bj][m][n];
                        *(f32x4*)(zout + off + bj * HALF + n * 16) = z;
                        s += (z[0] + z[1]) + (z[2] + z[3]); q += (z[0] * z[0] + z[1] * z[1]) + (z[2] * z[2] + z[3] * z[3]);
                    }
                s += __shfl_xor(s, 16); s += __shfl_xor(s, 32); q += __shfl_xor(q, 16); q += __shfl_xor(q, 32);
                if (fq == 0) stats[(size_t)row * 16 + u.pn * 4 + wc] = (f32x2v){s, q};
            }
    }
};
struct EpiSwiGLU {
    static constexpr bool PERM = true, AFTER_DRAIN = false;
    bf16_t* H;
    __device__ __forceinline__ void operator()(const f32x4 (&acc)[2][2][4][2], const Unit& u, int wr, int wc, int fr, int fq) const {
        const int row0 = u.pm * BM + wr * 64 + fr, col = u.pn * HALF + wc * 32 + 8 * fq;
#pragma unroll
        for (int ai = 0; ai < 2; ++ai)
#pragma unroll
            for (int m = 0; m < 4; ++m) {
                f32x4 o[2];
#pragma unroll
                for (int n = 0; n < 2; ++n)
#pragma unroll
                    for (int e = 0; e < 4; ++e) { const float g = acc[ai][0][m][n][e]; o[n][e] = g * sigmoidf_(g) * acc[ai][1][m][n][e]; }
                u32x4 w; w.x = cvt_pk_bf16(o[0][0], o[0][1]); w.y = cvt_pk_bf16(o[0][2], o[0][3]); w.z = cvt_pk_bf16(o[1][0], o[1][1]); w.w = cvt_pk_bf16(o[1][2], o[1][3]);
                *(u32x4*)(H + (size_t)(row0 + ai * HALF + m * 16) * DFF + col) = w;
            }
    }
};
}

__device__ __forceinline__ void p0_transpose_item(const float* W, int K, int N, bf16* WT, int dst_row0, int src_col0, int kb, LAS float* scr, int lane) {
    const int k0 = 64 * kb;
#pragma unroll 8
    for (int i = 0; i < 32; ++i) { const int kk = 2 * i + (lane >> 5); scr[kk * 33 + (lane & 31)] = W[(size_t)(k0 + kk) * N + src_col0 + (lane & 31)]; }
    asm volatile("s_waitcnt lgkmcnt(0)" ::: "memory");
    const int c = lane & 7;
#pragma unroll
    for (int j = 0; j < 4; ++j) { const int n = (lane >> 3) + 8 * j; const LAS float* s = scr + (8 * c) * 33 + n;
        u32x4 o; o.x = pk2(s[0 * 33], s[1 * 33]); o.y = pk2(s[2 * 33], s[3 * 33]); o.z = pk2(s[4 * 33], s[5 * 33]); o.w = pk2(s[6 * 33], s[7 * 33]);
        *(u32x4*)(WT + (size_t)(dst_row0 + n) * K + k0 + 8 * c) = o; }
    asm volatile("s_waitcnt lgkmcnt(0)" ::: "memory");
}
__device__ __forceinline__ int win_src(int p_abs) {
    const int pn = p_abs >> 8, p = p_abs & 255;
    if (pn <= 16) { const int bj = p >> 7, hh = (p & 127) >> 5; return pn * 256 + 64 * hh + 32 * bj; }
    return p_abs;
}
__device__ __forceinline__ int wgu_src(int p_abs) {
    const int pn = p_abs >> 8, p = p_abs & 255, bj = p >> 7, j = p & 127; return bj * DFF + pn * 128 + j;
}

__device__ __forceinline__ void phase0(const Args& a, LAS unsigned char* lds, int wave, int lane) {
    asm volatile("" : "+v"(lane));
    LAS float* scr = (LAS float*)(lds + wave * 16384);
    const int gw = blockIdx.x * NWAVES + wave, NGW = gridDim.x * NWAVES;
    unsigned char* ws = a.ws;
    for (int it = gw; it < 96 * 8; it += NGW) {
        const int cgp = it % 96, kc = it / 96;
        for (int idx = lane; idx < 2048; idx += 64) { const int b = idx >> 7, k = idx & 127; const float cv = a.c[b * D + kc * 128 + k]; scr[idx] = cv * sigmoidf_(cv); }
        asm volatile("s_waitcnt lgkmcnt(0)" ::: "memory");
        float acc[16];
#pragma unroll
        for (int b = 0; b < 16; ++b) acc[b] = 0.f;
        const float* wp = a.w_ada + (size_t)(kc * 128) * MODW + cgp * 64 + lane;
        for (int k = 0; k < 128; k += 4) {
            const float w0 = wp[(size_t)(k + 0) * MODW], w1 = wp[(size_t)(k + 1) * MODW], w2 = wp[(size_t)(k + 2) * MODW], w3 = wp[(size_t)(k + 3) * MODW];
#pragma unroll
            for (int b = 0; b < 16; ++b) { const f32x4 cv = *(const LAS f32x4*)(scr + b * 128 + k); acc[b] += cv[0] * w0 + cv[1] * w1 + cv[2] * w2 + cv[3] * w3; }
        }
        float* mp = (float*)(ws + WS_MODP) + (size_t)kc * 16 * MODW + cgp * 64 + lane;
        const float bias = (kc == 0) ? a.b_ada[cgp * 64 + lane] : 0.f;
#pragma unroll
        for (int b = 0; b < 16; ++b) mp[(size_t)b * MODW] = acc[b] + bias;
        asm volatile("s_waitcnt lgkmcnt(0)" ::: "memory");
    }
    constexpr int I_IN = 16 * 248, I_A = 16 * 32, I_B = 8 * 32, I_O = 16 * 32, I_GU = 16 * 176, I_D = 44 * 32;
    constexpr int NITEMS = I_IN + I_A + I_B + I_O + I_GU + I_D;
    for (int it = gw; it < NITEMS; it += NGW) {
        int r = it;
        if (r < I_IN) { const int nb = r % 248, kb = r / 248; p0_transpose_item(a.w_in, 1024, INW, (bf16*)(ws + WS_WIN), 32 * nb, win_src(32 * nb), kb, scr, lane); continue; } r -= I_IN;
        if (r < I_A) { const int nb = r % 32, kb = r / 32; p0_transpose_item(a.w_a, 1024, 1024, (bf16*)(ws + WS_WA), 32 * nb, 32 * nb, kb, scr, lane); continue; } r -= I_A;
        if (r < I_B) { const int nb = r % 32, kb = r / 32; p0_transpose_item(a.w_b, 512, 1024, (bf16*)(ws + WS_WB), 32 * nb, 32 * nb, kb, scr, lane); continue; } r -= I_B;
        if (r < I_O) { const int nb = r % 32, kb = r / 32; p0_transpose_item(a.w_o, 1024, 1024, (bf16*)(ws + WS_WO), 32 * nb, 32 * nb, kb, scr, lane); continue; } r -= I_O;
        if (r < I_GU) { const int nb = r % 176, kb = r / 176; p0_transpose_item(a.w_gu, 1024, 2 * DFF, (bf16*)(ws + WS_WGU), 32 * nb, wgu_src(32 * nb), kb, scr, lane); continue; } r -= I_GU;
        { const int nb = r % 32, kb = r / 32; p0_transpose_item(a.w_d, DFF, 1024, (bf16*)(ws + WS_WD), 32 * nb, 32 * nb, kb, scr, lane); }
    }
    {
        f32x2v* rope = (f32x2v*)(ws + WS_ROPE);
        const int gt = blockIdx.x * (NWAVES * 64) + threadIdx.x, NT = gridDim.x * NWAVES * 64;
        for (int idx = gt; idx < M * 32; idx += NT) {
            const int row = idx >> 5, i = idx & 31;
            const float inv = exp2f(-(float)i * (13.287712379549449f / 32.0f));
            const float ang = (float)a.pos[row] * inv;
            double rev = (double)ang * 0.15915494309189535; rev -= floor(rev);
            const float fr = (float)rev;
            rope[idx] = (f32x2v){__builtin_amdgcn_cosf(fr), __builtin_amdgcn_sinf(fr)};
        }
    }
}

__device__ __forceinline__ void phase1(const Args& a, LAS unsigned char* lds, int wave, int lane) {
    asm volatile("" : "+v"(lane));
    unsigned char* ws = a.ws; const float* modp = (const float*)(ws + WS_MODP); float* mod = (float*)(ws + WS_MOD);
    const int tid = threadIdx.x;
    for (int idx = blockIdx.x * 512 + tid; idx < 16 * MODW; idx += gridDim.x * 512) {
        float s = 0.f;
#pragma unroll
        for (int kc = 0; kc < 8; ++kc) s += modp[(size_t)kc * 16 * MODW + idx];
        mod[idx] = s;
    }
    LAS float* ss = (LAS float*)lds;
    bf16* U = (bf16*)(ws + WS_U);
    for (int chunk = blockIdx.x; chunk < M / 128; chunk += gridDim.x) {
        const int b = chunk / (T / 128);
        __syncthreads();
        for (int idx = tid; idx < 2048; idx += 512) {
            float s = 0.f;
#pragma unroll
            for (int kc = 0; kc < 8; ++kc) s += modp[(size_t)kc * 16 * MODW + (size_t)b * MODW + idx];
            ss[idx] = s;
        }
        __syncthreads();
        for (int rr = wave; rr < 128; rr += NWAVES) {
            const int row = chunk * 128 + rr;
            const f32x4* xr = (const f32x4*)(a.x + (size_t)row * D) + lane;
            unsigned long long* o8 = (unsigned long long*)(U + (size_t)row * D) + lane;
#pragma unroll
            for (int j = 0; j < 4; ++j) {
                const f32x4 v = xr[64 * j]; const int col = 4 * lane + 256 * j;
                const f32x4 sh = *(const LAS f32x4*)(ss + col), sc = *(const LAS f32x4*)(ss + 1024 + col);
                const f32x4 uu = v * (sc + 1.0f) + sh;
                o8[64 * j] = (unsigned long long)pk2(uu[0], uu[1]) | ((unsigned long long)pk2(uu[2], uu[3]) << 32);
            }
        }
    }
    __syncthreads();
}

__device__ __forceinline__ int crow(int r, int hi) { return (r & 3) + 8 * (r >> 2) + 4 * hi; }
template <bool PROBE> __device__ __forceinline__ void attn_phase(const Args& a, LAS unsigned char* lds, int wave, int lane) {
    asm volatile("" : "+v"(lane));
    unsigned char* ws = a.ws;
    const int r32 = lane & 31, hi = lane >> 5;
    LAS unsigned char* vt = lds + wave * 4096;
    const unsigned vaddr = (unsigned)(uintptr_t)vt + (4 * hi + ((lane & 15) >> 2)) * 64 + ((lane >> 4) & 1) * 32 + (lane & 3) * 8;
    const int vkey = lane >> 3, vch = lane & 7;
    LAS unsigned char* vwr = vt + (vch >> 2) * 2048 + vkey * 64 + (vch & 3) * 16;
    for (int bi = blockIdx.x; bi < 5120; bi += gridDim.x) {
        const int it = bi * 8 + wave;
        const bf16 *Q, *K, *V; bf16* O; int qp, kp, r, res, b, qs, nback; float sink2 = 0.f; bool has_sink; float* lse = nullptr;
        if (it < 16384) {
            const int g = it & 7; qs = (it >> 3) & 63; const int kvh = (it >> 9) & 1; b = it >> 10; r = 1; res = 0;
            const int hq = kvh * 8 + g;
            Q = (const bf16*)(ws + WS_QA) + hq * 64; qp = 1024; K = (const bf16*)(ws + WS_KVA) + kvh * 64; V = K + 128; kp = 256; O = (bf16*)(ws + WS_QA) + hq * 64;
            nback = 127; has_sink = true; sink2 = a.sinks[hq] * LOG2E;
        } else {
            const int it2 = it - 16384, grp = it2 >> 13, it3 = it2 & 8191, j = it3 & 7; b = it3 >> 9;
            if (grp == 0) { qs = (it3 >> 3) & 63; r = 1; res = 0; }
            else if (grp == 1) { qs = (it3 >> 3) & 15; res = (it3 >> 7) & 3; r = 4; }
            else { qs = (it3 >> 3) & 3; res = (it3 >> 5) & 15; r = 16; }
            const int h = grp * 8 + j;
            Q = (const bf16*)(ws + WS_QB) + h * 64; qp = 1536; K = (const bf16*)(ws + WS_KB) + h * 64; V = (const bf16*)(ws + WS_VB) + h * 64; kp = 1536; O = (bf16*)(ws + WS_QB) + h * 64;
            nback = 128; has_sink = false; lse = (float*)(ws + WS_LSE) + (size_t)grp * M * 8 + j;
        }
        const int q0 = qs * 32; const int tokbase = b * T + res;
        const int jstart = q0 >= 128 ? 0 : ((128 - q0) >> 5);
        const size_t qtok = (size_t)(tokbase + r * (q0 + r32));
        bf16x8 qf[4];
#pragma unroll
        for (int d0 = 0; d0 < 4; ++d0) qf[d0] = *(const bf16x8*)(Q + qtok * qp + d0 * 16 + hi * 8);
        f32x16 S[5];
#pragma unroll
        for (int j = 0; j < 5; ++j) {
            if (j >= jstart) {
                const int kt0 = q0 - 128 + 32 * j;
                const bf16* kr = K + (size_t)(tokbase + r * (kt0 + r32)) * kp + hi * 8;
                bf16x8 kf[4];
#pragma unroll
                for (int d0 = 0; d0 < 4; ++d0) kf[d0] = *(const bf16x8*)(kr + d0 * 16);
                f32x16 s = {};
#pragma unroll
                for (int d0 = 0; d0 < 4; ++d0) s = __builtin_amdgcn_mfma_f32_32x32x16_bf16(kf[d0], qf[d0], s, 0, 0, 0);
                S[j] = s;
            } else S[j] = f32x16{};
        }
        if (jstart == 0) {
#pragma unroll
            for (int rr = 0; rr < 16; ++rr) { const int dist = 128 + r32 - crow(rr, hi); if (dist > nback) S[0][rr] = -INFINITY; }
        }
#pragma unroll
        for (int rr = 0; rr < 16; ++rr) { if (r32 - crow(rr, hi) < 0) S[4][rr] = -INFINITY; }
        float mx = -INFINITY;
#pragma unroll
        for (int j = 0; j < 5; ++j) if (j >= jstart) {
#pragma unroll
            for (int rr = 0; rr < 16; ++rr) mx = fmaxf(mx, S[j][rr]);
        }
        mx = fmaxf(mx, __shfl_xor(mx, 32));
        if (has_sink) mx = fmaxf(mx, sink2);
        float ls = 0.f;
#pragma unroll
        for (int j = 0; j < 5; ++j) if (j >= jstart) {
#pragma unroll
            for (int rr = 0; rr < 16; ++rr) { const float p = __builtin_amdgcn_exp2f(S[j][rr] - mx); S[j][rr] = p; ls += p; }
        }
        ls += __shfl_xor(ls, 32);
        if (has_sink) ls += __builtin_amdgcn_exp2f(sink2 - mx);
        f32x16 OT[2]; OT[0] = f32x16{}; OT[1] = f32x16{};
#pragma unroll
        for (int j = 0; j < 5; ++j) if (j >= jstart) {
            const int kt0 = q0 - 128 + 32 * j;
            u32x4 vv[4];
#pragma unroll
            for (int i4 = 0; i4 < 4; ++i4) vv[i4] = *(const u32x4*)(V + (size_t)(tokbase + r * (kt0 + vkey + 8 * i4)) * kp + vch * 8);
#pragma unroll
            for (int i4 = 0; i4 < 4; ++i4) *(LAS u32x4*)(vwr + i4 * 512) = vv[i4];
            u32x4 pw[2];
#pragma unroll
            for (int kh = 0; kh < 2; ++kh) { pw[kh].x = pk2(S[j][8 * kh + 0], S[j][8 * kh + 1]); pw[kh].y = pk2(S[j][8 * kh + 2], S[j][8 * kh + 3]); pw[kh].z = pk2(S[j][8 * kh + 4], S[j][8 * kh + 5]); pw[kh].w = pk2(S[j][8 * kh + 6], S[j][8 * kh + 7]); }
            s16x4 lo[2][2], hh[2][2];
#define TRRD(dst, off) asm volatile("ds_read_b64_tr_b16 %0, %1 offset:" #off : "=&v"(dst) : "v"(vaddr) : "memory")
            TRRD(lo[0][0], 0);    TRRD(hh[0][0], 512);  TRRD(lo[0][1], 1024); TRRD(hh[0][1], 1536);
            TRRD(lo[1][0], 2048); TRRD(hh[1][0], 2560); TRRD(lo[1][1], 3072); TRRD(hh[1][1], 3584);
#undef TRRD
            asm volatile("s_waitcnt lgkmcnt(0)" : "+v"(lo[0][0]), "+v"(lo[0][1]), "+v"(lo[1][0]), "+v"(lo[1][1]), "+v"(hh[0][0]), "+v"(hh[0][1]), "+v"(hh[1][0]), "+v"(hh[1][1]) :: "memory");
#pragma unroll
            for (int db = 0; db < 2; ++db)
#pragma unroll
                for (int kh = 0; kh < 2; ++kh) {
                    const bf16x8 af = (bf16x8){lo[db][kh][0], lo[db][kh][1], lo[db][kh][2], lo[db][kh][3], hh[db][kh][0], hh[db][kh][1], hh[db][kh][2], hh[db][kh][3]};
                    OT[db] = __builtin_amdgcn_mfma_f32_32x32x16_bf16(af, __builtin_bit_cast(bf16x8, pw[kh]), OT[db], 0, 0, 0);
                }
        }
        const float inv_l = 1.0f / ls;
        bf16* op = O + qtok * qp;
        if (PROBE) op = (bf16*)(ws + WS_U + ((size_t)((unsigned char*)op - ws) & (64 * MiB - 1)));
#pragma unroll
        for (int db = 0; db < 2; ++db)
#pragma unroll
            for (int rg = 0; rg < 4; ++rg) {
                u32x2 w; w.x = pk2(OT[db][4 * rg + 0] * inv_l, OT[db][4 * rg + 1] * inv_l); w.y = pk2(OT[db][4 * rg + 2] * inv_l, OT[db][4 * rg + 3] * inv_l);
                *(u32x2*)(op + 32 * db + 8 * rg + 4 * hi) = w;
            }
        if (lse != nullptr && hi == 0) lse[qtok * 8] = mx + __builtin_amdgcn_logf(ls);
    }
}

__device__ __forceinline__ void merge_pass(const Args& a, int wave, int lane) {
    asm volatile("" : "+v"(lane));
    unsigned char* ws = a.ws; const bf16* OG = (const bf16*)(ws + WS_QB); const float* LSE = (const float*)(ws + WS_LSE); bf16* OB = (bf16*)(ws + WS_OB);
    const int gw = blockIdx.x * NWAVES + wave, NGW = gridDim.x * NWAVES; const int j = lane >> 3, ch = lane & 7;
    for (int row = gw; row < M; row += NGW) {
        const float l0 = LSE[(size_t)row * 8 + j], l1 = LSE[(size_t)M * 8 + (size_t)row * 8 + j], l2 = LSE[(size_t)2 * M * 8 + (size_t)row * 8 + j];
        const float mx = fmaxf(l0, fmaxf(l1, l2));
        float e0 = __builtin_amdgcn_exp2f(l0 - mx), e1 = __builtin_amdgcn_exp2f(l1 - mx), e2 = __builtin_amdgcn_exp2f(l2 - mx);
        const float inv = 1.0f / (e0 + e1 + e2); e0 *= inv; e1 *= inv; e2 *= inv;
        const bf16* p = OG + (size_t)row * 1536 + j * 64 + ch * 8;
        const u32x4 a0 = *(const u32x4*)(p), a1 = *(const u32x4*)(p + 512), a2 = *(const u32x4*)(p + 1024);
        u32x4 o;
        o.x = pk2(e0 * bflo(a0.x) + e1 * bflo(a1.x) + e2 * bflo(a2.x), e0 * bfhi(a0.x) + e1 * bfhi(a1.x) + e2 * bfhi(a2.x));
        o.y = pk2(e0 * bflo(a0.y) + e1 * bflo(a1.y) + e2 * bflo(a2.y), e0 * bfhi(a0.y) + e1 * bfhi(a1.y) + e2 * bfhi(a2.y));
        o.z = pk2(e0 * bflo(a0.z) + e1 * bflo(a1.z) + e2 * bflo(a2.z), e0 * bfhi(a0.z) + e1 * bfhi(a1.z) + e2 * bfhi(a2.z));
        o.w = pk2(e0 * bflo(a0.w) + e1 * bflo(a1.w) + e2 * bflo(a2.w), e0 * bfhi(a0.w) + e1 * bfhi(a1.w) + e2 * bfhi(a2.w));
        *(u32x4*)(OB + (size_t)row * 512 + j * 64 + ch * 8) = o;
    }
}

template <bool FIRST> __device__ __forceinline__ void ln_pass(const Args& a, int wave, int lane) {
    asm volatile("" : "+v"(lane));
    unsigned char* ws = a.ws;
    const f32x2v* st = (const f32x2v*)(ws + (FIRST ? WS_ST1 : WS_ST2));
    const float* zin = FIRST ? (const float*)(ws + WS_Z) : a.out;
    const float* lg = FIRST ? a.ln1g : a.ln2g; const float* lb = FIRST ? a.ln1b : a.ln2b;
    const float* mod = (const float*)(ws + WS_MOD);
    const int gw = blockIdx.x * NWAVES + wave, NGW = gridDim.x * NWAVES;
    for (int row = gw; row < M; row += NGW) {
        f32x2v p = st[(size_t)row * 16 + (lane & 15)];
        float s = p.x, q = p.y;
#pragma unroll
        for (int o = 1; o < 16; o <<= 1) { s += __shfl_xor(s, o); q += __shfl_xor(q, o); }
        const float mean = s * (1.0f / D); const float var = fmaxf(q * (1.0f / D) - mean * mean, 0.f); const float rstd = 1.0f / sqrtf(var + LN_EPS);
        if (FIRST && lane == 0) ((f32x2v*)(ws + WS_RSTAT))[row] = (f32x2v){mean, rstd};
        const int b = row / T;
        const f32x4* zr = (const f32x4*)(zin + (size_t)row * D) + lane;
#pragma unroll
        for (int j = 0; j < 4; ++j) {
            const int col = 4 * lane + 256 * j;
            const f32x4 z = zr[64 * j]; const f32x4 g = *(const f32x4*)(lg + col), bb = *(const f32x4*)(lb + col);
            const f32x4 x1 = (z - mean) * rstd * g + bb;
            if (FIRST) {
                const f32x4 sh = *(const f32x4*)(mod + (size_t)b * MODW + 3 * D + col), sc = *(const f32x4*)(mod + (size_t)b * MODW + 4 * D + col);
                const f32x4 uu = x1 * (sc + 1.0f) + sh;
                ((unsigned long long*)((bf16*)(ws + WS_U) + (size_t)row * D))[lane + 64 * j] = (unsigned long long)pk2(uu[0], uu[1]) | ((unsigned long long)pk2(uu[2], uu[3]) << 32);
            } else {
                ((f32x4*)(a.out + (size_t)row * D))[lane + 64 * j] = x1;
            }
        }
    }
}

#define XB_TMO      128
#define XB_XCNT(j)  (256  + 64 * (j))
#define XB_XSUB(j)  (1280 + 64 * (j))
#define XB_XGEN(j)  (2304 + 64 * (j))
#define XB_TOP      3328
#define XB_TOPGEN   3392
#define XCD_BAR_WORDS 3456
#define XB_SPIN_CAP (1u << 18)

__device__ __forceinline__ unsigned xb_ld(unsigned* p)              { return __hip_atomic_load(p, __ATOMIC_RELAXED, __HIP_MEMORY_SCOPE_AGENT); }
__device__ __forceinline__ unsigned xb_add(unsigned* p, unsigned v) { return __hip_atomic_fetch_add(p, v, __ATOMIC_RELAXED, __HIP_MEMORY_SCOPE_AGENT); }
__device__ __forceinline__ unsigned xb_xcc_id() { return (unsigned)__builtin_amdgcn_s_getreg((3 << 11) | 20) & 0xFu; }
#define XB_SPIN(cond, bar) do { unsigned _sp = 0; while (cond) { __builtin_amdgcn_s_sleep(1); \
    if ((++_sp & 255u) == 0u) { if (xb_ld(&(bar)[XB_TMO])) break; if (_sp > XB_SPIN_CAP) { atomicAdd(&(bar)[XB_TMO], 1u); break; } } } } while (0)

struct XcdBarrier {
    unsigned* bar; unsigned x;
    volatile LAS unsigned* st;
};

__device__ __forceinline__ XcdBarrier xcd_barrier_post(unsigned* bar, volatile LAS unsigned* st) {
    XcdBarrier b; b.bar = bar; b.x = xb_xcc_id(); b.st = st;
    if (threadIdx.x == 0) (void)xb_add(&bar[XB_XCNT(b.x)], 1u);
    return b;
}
__device__ __forceinline__ void xcd_barrier_complete(unsigned* bar, unsigned x, unsigned& nloc, unsigned& nx) {
    const unsigned G = gridDim.x * gridDim.y * gridDim.z;
    unsigned sum, cnt, mine, sp = 0u;
    for (;;) {
        sum = 0u; cnt = 0u; mine = 0u;
#pragma unroll
        for (unsigned j = 0; j < 16; ++j) { const unsigned c = xb_ld(&bar[XB_XCNT(j)]); sum += c; cnt += (c > 0u) ? 1u : 0u; mine = (j == x) ? c : mine; }
        if (sum == G) break;
        __builtin_amdgcn_s_sleep(1);
        if ((++sp & 255u) == 0u) { if (xb_ld(&bar[XB_TMO])) break; if (sp > XB_SPIN_CAP) { atomicAdd(&bar[XB_TMO], 1u); break; } }
    }
    nloc = mine > 0u ? mine : 1u; nx = cnt > 0u ? cnt : 1u;
}

__device__ __forceinline__ void xcd_barrier(const XcdBarrier& b) {
    asm volatile("s_waitcnt vmcnt(0)" ::: "memory");
    __syncthreads();
    if (threadIdx.x == 0) {
        unsigned* bar = b.bar;
        __builtin_amdgcn_s_waitcnt(0);
        unsigned nloc = b.st[0], nx = b.st[1];
        if (nloc == 0u) { xcd_barrier_complete(bar, b.x, nloc, nx); b.st[0] = nloc; b.st[1] = nx; }
        const unsigned old = xb_add(&bar[XB_XSUB(b.x)], 1u);
        const unsigned gen = old / nloc;
        if (old + 1u == (gen + 1u) * nloc) {
            __builtin_amdgcn_fence(__ATOMIC_RELEASE, "agent");
            asm volatile("s_waitcnt vmcnt(0)" ::: "memory");
            const unsigned og = xb_add(&bar[XB_TOP], 1u);
            const unsigned tg = og / nx;
            if (og + 1u == (tg + 1u) * nx) xb_add(&bar[XB_TOPGEN], 1u);
            else XB_SPIN(xb_ld(&bar[XB_TOPGEN]) == tg, bar);
            __builtin_amdgcn_fence(__ATOMIC_ACQUIRE, "agent");
            xb_add(&bar[XB_XGEN(b.x)], 1u);
            asm volatile("s_waitcnt vmcnt(0)" ::: "memory");
        } else {
            XB_SPIN(xb_ld(&bar[XB_XGEN(b.x)]) == gen, bar);
            __builtin_amdgcn_fence(__ATOMIC_ACQUIRE, "agent");
            asm volatile("s_waitcnt vmcnt(0)" ::: "memory");
        }
    }
    __syncthreads();
}

#ifndef PH_HI
#define PH_HI 99
#endif
#ifdef PROBE_SYNC
#define GSYNC() do { xcd_barrier(bar); xcd_barrier(bar); } while (0)
#else
#define GSYNC() xcd_barrier(bar)
#endif
__global__ void __launch_bounds__(NWAVES * 64, 2) mega_fwd(Args a) {
    extern __shared__ __attribute__((aligned(16))) unsigned char lds_raw[];
    LAS unsigned char* lds = (LAS unsigned char*)lds_raw;
    cg::grid_group grid = cg::this_grid();
    const int tid = threadIdx.x, lane = tid & 63, wave = __builtin_amdgcn_readfirstlane(tid >> 6);
    unsigned char* ws = a.ws;
    bf16* GA = (bf16*)a.out; bf16* GB = GA + (size_t)M * 1024;
    const int G = gridDim.x, c = blockIdx.x;

    if (tid < 2) ((volatile LAS unsigned*)(lds + LDS_MISC))[tid] = 0u;
    if (blockIdx.x == 0) { for (int i = tid; i < XCD_BAR_WORDS; i += NWAVES * 64) ((unsigned*)(ws + WS_BAR))[i] = 0u; }
    phase0(a, lds, wave, lane);
    grid.sync();
    XcdBarrier bar = xcd_barrier_post((unsigned*)(ws + WS_BAR), (volatile LAS unsigned*)(lds + LDS_MISC));
    phase1(a, lds, wave, lane);
    GSYNC();
    {
        pg8::Gemm g{(const bf16*)(ws + WS_U), (const bf16*)(ws + WS_WIN), M, INW, 1024}; pg8::StaticOrder S; S.init(M, INW, G, c);
        pg8::EpiInProj E{ws, GA, (const f32x4*)(ws + WS_ROPE)};
#ifdef PROBE_GEMM
        pg8::gemm_phase<pg8::EpiInProj, pg8::StaticOrder, true, true>(lds, g, S, E);
#endif
        pg8::gemm_phase<pg8::EpiInProj, pg8::StaticOrder, true, true>(lds, g, S, E);
    }
    GSYNC();
#ifdef PROBE_ATTN
    attn_phase<true>(a, lds, wave, lane);
#endif
    attn_phase<false>(a, lds, wave, lane);
    GSYNC();
    merge_pass(a, wave, lane);
    {
        pg8::Gemm g{(const bf16*)(ws + WS_QA), (const bf16*)(ws + WS_WA), M, 1024, 1024}; pg8::StaticOrder S; S.init(M, 1024, G, c);
        pg8::EpiGate<false> E{(bf16*)(ws + WS_YAS), GA, nullptr};
#ifdef PROBE_GEMM
        pg8::gemm_phase<pg8::EpiGate<false>, pg8::StaticOrder, true, true>(lds, g, S, E);
#endif
        pg8::gemm_phase<pg8::EpiGate<false>, pg8::StaticOrder, true, true>(lds, g, S, E);
    }
    GSYNC();
    {
        pg8::Gemm g{(const bf16*)(ws + WS_OB), (const bf16*)(ws + WS_WB), M, 1024, 512}; pg8::StaticOrder S; S.init(M, 1024, G, c);
        pg8::EpiGate<true> E{(bf16*)(ws + WS_MERGED), GB, (const bf16*)(ws + WS_YAS)};
#ifdef PROBE_GEMM
        pg8::gemm_phase<pg8::EpiGate<true>, pg8::StaticOrder, true, true>(lds, g, S, E);
#endif
        pg8::gemm_phase<pg8::EpiGate<true>, pg8::StaticOrder, true, true>(lds, g, S, E);
    }
    GSYNC();
    {
        pg8::Gemm g{(const bf16*)(ws + WS_MERGED), (const bf16*)(ws + WS_WO), M, 1024, 1024}; pg8::StaticOrder S; S.init(M, 1024, G, c);
        pg8::EpiRes<false> E{a.x, (float*)(ws + WS_Z), (const float*)(ws + WS_MOD) + 2 * D, (f32x2v*)(ws + WS_ST1), nullptr, nullptr, nullptr};
#ifdef PROBE_GEMM
        pg8::gemm_phase<pg8::EpiRes<false>, pg8::StaticOrder, true, true>(lds, g, S, E);
#endif
        pg8::gemm_phase<pg8::EpiRes<false>, pg8::StaticOrder, true, true>(lds, g, S, E);
    }
    GSYNC();
    ln_pass<true>(a, wave, lane);
    GSYNC();
    {
        pg8::Gemm g{(const bf16*)(ws + WS_U), (const bf16*)(ws + WS_WGU), M, 2 * DFF, 1024}; pg8::StaticOrder S; S.init(M, 2 * DFF, G, c);
        pg8::EpiSwiGLU E{(bf16*)(ws + WS_H)};
#ifdef PROBE_GEMM
        pg8::gemm_phase<pg8::EpiSwiGLU, pg8::StaticOrder, true, true>(lds, g, S, E);
#endif
        pg8::gemm_phase<pg8::EpiSwiGLU, pg8::StaticOrder, true, true>(lds, g, S, E);
    }
    GSYNC();
    {
        pg8::Gemm g{(const bf16*)(ws + WS_H), (const bf16*)(ws + WS_WD), M, 1024, DFF}; pg8::StaticOrder S; S.init(M, 1024, G, c);
        pg8::EpiRes<true> E{(const float*)(ws + WS_Z), a.out, (const float*)(ws + WS_MOD) + 5 * D, (f32x2v*)(ws + WS_ST2), (const f32x2v*)(ws + WS_RSTAT), a.ln1g, a.ln1b};
#ifdef PROBE_GEMM
        pg8::gemm_phase<pg8::EpiRes<true>, pg8::StaticOrder, true, true>(lds, g, S, E);
#endif
        pg8::gemm_phase<pg8::EpiRes<true>, pg8::StaticOrder, true, true>(lds, g, S, E);
    }
    GSYNC();
    ln_pass<false>(a, wave, lane);
}

extern "C" void kernel_launch(void* const* d_in, const int* in_sizes, int n_in, void* d_out, int out_size, void* d_ws, size_t ws_size, hipStream_t stream) {
    static int grid = 0;
    if (grid == 0) {
        if (n_in != 16 || in_sizes[0] != M * D || out_size != M * D || ws_size < WS_END) {
            fprintf(stderr, "kernel_launch: unexpected shapes: n_in %d in0 %d out %d ws %zu (need %zu)\n", n_in, n_in > 0 ? in_sizes[0] : -1, out_size, ws_size, (size_t)WS_END); grid = -1; return; }
        int dev = 0, cus = 0, per_cu = 0;
        hipGetDevice(&dev); hipDeviceGetAttribute(&cus, hipDeviceAttributeMultiprocessorCount, dev);
        if (hipFuncSetAttribute((const void*)mega_fwd, hipFuncAttributeMaxDynamicSharedMemorySize, LDS_BYTES) != hipSuccess) { fprintf(stderr, "kernel_launch: hipFuncSetAttribute failed\n"); grid = -1; return; }
        if (hipOccupancyMaxActiveBlocksPerMultiprocessor(&per_cu, (const void*)mega_fwd, NWAVES * 64, LDS_BYTES) != hipSuccess || per_cu < 1) { fprintf(stderr, "kernel_launch: occupancy query failed (%d)\n", per_cu); per_cu = 1; }
        (void)hipGetLastError();
        grid = cus * (per_cu > 1 ? 1 : per_cu);
        if (grid < 8) grid = 8;
    }
    if (grid < 0) return;
    Args a{};
    a.x = (const float*)d_in[0]; a.c = (const float*)d_in[1]; a.pos = (const int*)d_in[2]; a.w_ada = (const float*)d_in[3]; a.b_ada = (const float*)d_in[4];
    a.w_in = (const float*)d_in[5]; a.sinks = (const float*)d_in[6]; a.w_a = (const float*)d_in[7]; a.w_b = (const float*)d_in[8]; a.w_o = (const float*)d_in[9];
    a.ln1g = (const float*)d_in[10]; a.ln1b = (const float*)d_in[11]; a.w_gu = (const float*)d_in[12]; a.w_d = (const float*)d_in[13]; a.ln2g = (const float*)d_in[14]; a.ln2b = (const float*)d_in[15];
    a.out = (float*)d_out; a.ws = (unsigned char*)d_ws;
    void* args[] = {&a};
    hipError_t e = hipLaunchCooperativeKernel((const void*)mega_fwd, dim3(grid), dim3(NWAVES * 64), args, LDS_BYTES, stream);
    if (e != hipSuccess) fprintf(stderr, "kernel_launch: cooperative launch failed: %s (grid %d)\n", hipGetErrorString(e), grid);
}
```

```cpp
#include <hip/hip_runtime.h>
#include <hip/hip_cooperative_groups.h>
#include <cstdio>
#include <cstdint>
namespace cg = cooperative_groups;
namespace pg8 {
#define PG8_LAS __attribute__((address_space(3)))
typedef unsigned short bf16_t;
typedef short bf16x8 __attribute__((ext_vector_type(8)));
typedef float f32x4 __attribute__((ext_vector_type(4)));
typedef unsigned u32x4 __attribute__((ext_vector_type(4)));
constexpr int BM = 256, BK = 64, HALF = 128, HTB = HALF * BK * 2  , STAGE_BYTES = 8 * HTB, NXCD = 8, WGM = 8;

__host__ __device__ __forceinline__ int lds_byte(int r, int c) { const int st = (r >> 4) * 2 + (c >> 5), rr = r & 15, cc = c & 31, ob = rr * 64 + cc * 2; return st * 1024 + (ob ^ (((ob >> 9) & 1) << 5)); }
__host__ __device__ __forceinline__ void stage_rc(int b, int& R, int& C) { const int st = b / 1024, sb = b % 1024, swz = sb ^ (((sb >> 9) & 1) << 5); R = (st >> 1) * 16 + swz / 64; C = (st & 1) * 32 + (swz % 64) / 2; }
__host__ __device__ __forceinline__ int perm32(int rho) { const int n = rho >> 4, i = rho & 15; return 8 * (i >> 2) + 4 * n + (i & 3); }

struct Unit { int pm, pn; };
struct Gemm { const bf16_t* A; const bf16_t* Bt; int M, N, K; };

struct StaticOrder {
    int nM, nN, nwg, G, c;
    __host__ __device__ void init(int M, int N, int G_, int c_) { nM = M / BM; nN = N / BM; nwg = nM * nN; G = G_; c = c_; }
    __host__ __device__ bool next(int i, Unit& u) const {
        const long L = (long)i * G + c; if (L >= nwg) return false;
        int wgid = (int)L; { const int q = nwg / NXCD, r = nwg % NXCD, xcd = wgid % NXCD, off = wgid / NXCD; wgid = (xcd < r ? xcd * (q + 1) : r * (q + 1) + (xcd - r) * q) + off; }
        const int nig = WGM * nN, gid = wgid / nig, fm = gid * WGM, gsz = (nM - fm) < WGM ? (nM - fm) : WGM;
        u.pm = fm + ((wgid % nig) % gsz); u.pn = (wgid % nig) / gsz; return true;
    }
    __device__ __forceinline__ void a_ready(const Unit&) const {}
    __device__ __forceinline__ void done(const Unit&) const {}
};

__device__ __forceinline__ unsigned cvt_pk_bf16(float lo, float hi) { unsigned r; asm volatile("v_cvt_pk_bf16_f32 %0, %1, %2" : "=v"(r) : "v"(lo), "v"(hi)); return r; }
typedef float f32x2 __attribute__((ext_vector_type(2)));
template <class Epi, class Sched, bool ALIGN_EPI = false, bool SP2 = false>
__device__ __forceinline__ void gemm_phase(PG8_LAS unsigned char* lds, const Gemm g, const Sched& S, const Epi& E) {
    int tid_ = threadIdx.x; asm volatile("" : "+v"(tid_));
    const int tid = tid_, wid = __builtin_amdgcn_readfirstlane(tid >> 6), lane = tid & 63, wr = wid >> 2, wc = wid & 3, fr = lane & 15, fq = lane >> 4;
    const int K = g.K, nt = K / BK;
    unsigned voffA[2], voffB[2];
#pragma unroll
    for (int i = 0; i < 2; ++i) { int R, C; stage_rc(tid * 16 + i * 8192, R, C); const int Rb = Epi::PERM ? ((R & ~31) + perm32(R & 31)) : R;
        voffA[i] = (unsigned)(R * K + C) * 2u; voffB[i] = (unsigned)(Rb * K + C) * 2u; }
    const size_t kstep = (size_t)(BK * 2);
    const size_t hstep = (size_t)HALF * K * 2;
    const size_t tstep = 2 * hstep;
    const unsigned ldsw = (unsigned)wid * 1024u;
    const int aoff = lds_byte(wr * 64 + fr, fq * 8), boff = lds_byte(wc * 32 + fr, fq * 8);
#define PG8_SA(b, h) (((b) * 2 + (h)) * HTB)
#define PG8_SB(b, h) ((4 + (b) * 2 + (h)) * HTB)
#define PG8_STAGE(bufoff, gbase, voff) do { _Pragma("unroll") for (int _i = 0; _i < 2; ++_i) \
        __builtin_amdgcn_global_load_lds((const unsigned*)((const char*)(gbase) + (voff)[_i]), (PG8_LAS unsigned*)(lds + (bufoff) + ldsw + _i * 8192), 16, 0, 0); } while (0)
#define PG8_LDA(dst, b, h) do { _Pragma("unroll") for (int m = 0; m < 4; ++m) _Pragma("unroll") for (int k = 0; k < 2; ++k) dst[m][k] = *(const PG8_LAS bf16x8*)(lds + PG8_SA(b, h) + aoff + m * 2048 + k * 1024); } while (0)
#define PG8_LDB(dst, b, h) do { _Pragma("unroll") for (int n = 0; n < 2; ++n) _Pragma("unroll") for (int k = 0; k < 2; ++k) dst[n][k] = *(const PG8_LAS bf16x8*)(lds + PG8_SB(b, h) + boff + n * 2048 + k * 1024); } while (0)
#define PG8_MMA(ai, bj, At, Bt) do { __builtin_amdgcn_s_setprio(1); _Pragma("unroll") for (int m = 0; m < 4; ++m) _Pragma("unroll") for (int n = 0; n < 2; ++n) _Pragma("unroll") for (int k = 0; k < 2; ++k) \
        acc[ai][bj][m][n] = __builtin_amdgcn_mfma_f32_16x16x32_bf16(Bt[n][k], At[m][k], acc[ai][bj][m][n], 0, 0, 0); __builtin_amdgcn_s_setprio(0); } while (0)
#define PG8_WAIT_V(n) asm volatile("s_waitcnt vmcnt(" #n ")" ::: "memory")
#define PG8_WAIT_L(n) asm volatile("s_waitcnt lgkmcnt(" #n ")" ::: "memory")
#define PG8_BAR __builtin_amdgcn_s_barrier()
#define PG8_SCHED __builtin_amdgcn_sched_barrier(0)
    Unit cur, nxt; int ui = 0;
    if (!S.next(0, cur)) return;
    f32x4 acc[2][2][4][2];
#pragma unroll
    for (int a = 0; a < 2; ++a)
#pragma unroll
        for (int b = 0; b < 2; ++b)
#pragma unroll
            for (int m = 0; m < 4; ++m)
#pragma unroll
                for (int n = 0; n < 2; ++n) acc[a][b][m][n] = (f32x4){0.f, 0.f, 0.f, 0.f};
    bf16x8 At[4][2], B0[2][2], B1[2][2];
    const char* cA = (const char*)g.A + (size_t)cur.pm * tstep; const char* cB = (const char*)g.Bt + (size_t)cur.pn * tstep;
    S.a_ready(cur);
    if constexpr (SP2) {
        PG8_STAGE(PG8_SB(0, 0), cB, voffB); PG8_STAGE(PG8_SB(0, 1), cB + hstep, voffB); PG8_STAGE(PG8_SA(0, 0), cA, voffA); PG8_STAGE(PG8_SA(0, 1), cA + hstep, voffA);
        if (wr == 1) PG8_BAR;
        PG8_WAIT_V(2); PG8_BAR;
        PG8_STAGE(PG8_SB(1, 0), cB + kstep, voffB); PG8_STAGE(PG8_SA(1, 0), cA + kstep, voffA); PG8_STAGE(PG8_SB(1, 1), cB + hstep + kstep, voffB);
        PG8_WAIT_V(6); PG8_BAR;
    } else {
        PG8_STAGE(PG8_SB(0, 0), cB, voffB); PG8_STAGE(PG8_SA(0, 0), cA, voffA); PG8_STAGE(PG8_SB(0, 1), cB + hstep, voffB); PG8_STAGE(PG8_SA(0, 1), cA + hstep, voffA);
        if (wr == 1) PG8_BAR;
        PG8_WAIT_V(4); PG8_BAR;
        PG8_STAGE(PG8_SB(1, 0), cB + kstep, voffB); PG8_STAGE(PG8_SA(1, 0), cA + kstep, voffA); PG8_STAGE(PG8_SB(1, 1), cB + hstep + kstep, voffB);
        PG8_WAIT_V(6); PG8_BAR;
    }
    for (;;) {
        const bool has_next = S.next(ui + 1, nxt);
        const char* nA = has_next ? (const char*)g.A + (size_t)nxt.pm * tstep : cA; const char* nB = has_next ? (const char*)g.Bt + (size_t)nxt.pn * tstep : cB;
        for (int t = 0; t < nt; t += 2) {
            const bool last = (t == nt - 2);
            const char* a1 = cA + (size_t)(t + 1) * kstep;
            const char* a2 = last ? nA : cA + (size_t)(t + 2) * kstep; const char* b2 = last ? nB : cB + (size_t)(t + 2) * kstep;
            const char* a3 = a2 + kstep; const char* b3 = b2 + kstep;
            if (last && has_next) S.a_ready(nxt);
            if constexpr (SP2) {
            PG8_LDB(B0, 0, 0); PG8_LDB(B1, 0, 1); PG8_SCHED; PG8_LDA(At, 0, 0); PG8_STAGE(PG8_SA(1, 1), a1 + hstep, voffA);
            PG8_WAIT_V(8); PG8_WAIT_L(0); PG8_BAR; PG8_MMA(0, 0, At, B0); PG8_MMA(0, 1, At, B1); PG8_BAR; PG8_SCHED;
            PG8_LDA(At, 0, 1); PG8_STAGE(PG8_SB(0, 0), b2, voffB); PG8_STAGE(PG8_SB(0, 1), b2 + hstep, voffB); PG8_STAGE(PG8_SA(0, 0), a2, voffA);
            PG8_WAIT_V(8); PG8_WAIT_L(0); PG8_BAR; PG8_MMA(1, 0, At, B0); PG8_MMA(1, 1, At, B1); PG8_BAR; PG8_SCHED;
            PG8_LDB(B0, 1, 0); PG8_LDB(B1, 1, 1); PG8_SCHED; PG8_LDA(At, 1, 0); PG8_STAGE(PG8_SA(0, 1), a2 + hstep, voffA);
            PG8_WAIT_V(8); PG8_WAIT_L(0); PG8_BAR; PG8_MMA(0, 0, At, B0); PG8_MMA(0, 1, At, B1); PG8_BAR; PG8_SCHED;
            PG8_LDA(At, 1, 1); PG8_STAGE(PG8_SB(1, 0), b3, voffB); PG8_STAGE(PG8_SB(1, 1), b3 + hstep, voffB); PG8_STAGE(PG8_SA(1, 0), a3, voffA);
            PG8_WAIT_V(8); PG8_WAIT_L(0); PG8_BAR; PG8_MMA(1, 0, At, B0); PG8_MMA(1, 1, At, B1); PG8_BAR; PG8_SCHED;
            } else {
            PG8_LDB(B0, 0, 0); PG8_SCHED; PG8_LDA(At, 0, 0); PG8_STAGE(PG8_SA(1, 1), a1 + hstep, voffA);
            PG8_WAIT_L(8); PG8_BAR; PG8_WAIT_L(0); PG8_MMA(0, 0, At, B0); PG8_BAR; PG8_SCHED;
            PG8_LDB(B1, 0, 1); PG8_STAGE(PG8_SB(0, 0), b2, voffB);
            PG8_BAR; PG8_WAIT_L(0); PG8_MMA(0, 1, At, B1); PG8_BAR;
            PG8_LDA(At, 0, 1); PG8_STAGE(PG8_SA(0, 0), a2, voffA);
            PG8_BAR; PG8_WAIT_L(0); PG8_MMA(1, 0, At, B0); PG8_BAR; PG8_SCHED;
            PG8_STAGE(PG8_SB(0, 1), b2 + hstep, voffB);
            PG8_WAIT_V(6); PG8_BAR; PG8_MMA(1, 1, At, B1); PG8_BAR;
            PG8_LDB(B0, 1, 0); PG8_SCHED; PG8_LDA(At, 1, 0); PG8_STAGE(PG8_SA(0, 1), a2 + hstep, voffA);
            PG8_WAIT_L(8); PG8_BAR; PG8_WAIT_L(0); PG8_MMA(0, 0, At, B0); PG8_BAR; PG8_SCHED;
            PG8_LDB(B1, 1, 1); PG8_STAGE(PG8_SB(1, 0), b3, voffB);
            PG8_BAR; PG8_WAIT_L(0); PG8_MMA(0, 1, At, B1); PG8_BAR;
            PG8_LDA(At, 1, 1); PG8_STAGE(PG8_SA(1, 0), a3, voffA);
            PG8_BAR; PG8_WAIT_L(0); PG8_MMA(1, 0, At, B0); PG8_BAR; PG8_SCHED;
            PG8_STAGE(PG8_SB(1, 1), b3 + hstep, voffB);
            PG8_WAIT_V(6); PG8_BAR; PG8_MMA(1, 1, At, B1); PG8_BAR;
            }
        }
        if constexpr (ALIGN_EPI) { if (wr == 0) PG8_BAR; }
        if constexpr (!Epi::AFTER_DRAIN) { E(acc, cur, wr, wc, fr, fq); S.done(cur); }
        if (!has_next) break;
#pragma unroll
        for (int a = 0; a < 2; ++a)
#pragma unroll
            for (int b = 0; b < 2; ++b)
#pragma unroll
                for (int m = 0; m < 4; ++m)
#pragma unroll
                    for (int n = 0; n < 2; ++n) acc[a][b][m][n] = (f32x4){0.f, 0.f, 0.f, 0.f};
        cur = nxt; cA = nA; cB = nB; ++ui;
        if constexpr (ALIGN_EPI) { if (wr == 1) PG8_BAR; }
    }
    PG8_WAIT_V(0);
    if constexpr (!ALIGN_EPI) { if (wr == 0) PG8_BAR; }
    PG8_BAR;
    if constexpr (Epi::AFTER_DRAIN) { E.fused(acc, cur, wr, wc, fr, fq, lds, wid, lane); S.done(cur); }
#undef PG8_SA
#undef PG8_SB
#undef PG8_STAGE
#undef PG8_LDA
#undef PG8_LDB
#undef PG8_MMA
#undef PG8_WAIT_V
#undef PG8_WAIT_L
#undef PG8_BAR
#undef PG8_SCHED
}
}

#define LAS __attribute__((address_space(3)))
typedef unsigned short bf16;
typedef float f32x4 __attribute__((ext_vector_type(4)));
typedef float f32x16 __attribute__((ext_vector_type(16)));
typedef unsigned u32x4 __attribute__((ext_vector_type(4)));
typedef unsigned u32x2 __attribute__((ext_vector_type(2)));
typedef short bf16x8 __attribute__((ext_vector_type(8)));
typedef short s16x4 __attribute__((ext_vector_type(4)));
typedef float f32x2v __attribute__((ext_vector_type(2)));

constexpr int NB = 16, T = 2048, D = 1024, M = NB * T;
constexpr int INW = 7936, DFF = 2816, MODW = 6 * D;
constexpr float LOG2E = 1.4426950408889634f;
constexpr float QSCALE = 0.125f * LOG2E;
constexpr float ALPHA = 1.189207115002721f;
constexpr float LN_EPS = 1e-5f;
constexpr int NWAVES = 8;

constexpr size_t MiB = 1u << 20;
constexpr size_t WS_MODP = 0, WS_MOD = 3 * MiB, WS_RSTAT = 3 * MiB + 512 * 1024, WS_LSE = 4 * MiB, WS_ROPE = 8 * MiB, WS_ST1 = 16 * MiB, WS_ST2 = 20 * MiB;
constexpr size_t WS_WIN = 24 * MiB, WS_WA = 40 * MiB, WS_WB = 42 * MiB, WS_WO = 43 * MiB, WS_WGU = 45 * MiB, WS_WD = 56 * MiB;
constexpr size_t WS_U = 64 * MiB, WS_QA = 128 * MiB, WS_KVA = 192 * MiB, WS_QB = 208 * MiB, WS_KB = 304 * MiB, WS_VB = 400 * MiB, WS_END = 496 * MiB;
constexpr size_t WS_Z2 = 64 * MiB;
constexpr size_t WS_OB = 64 * MiB, WS_YAS = 304 * MiB, WS_MERGED = 368 * MiB, WS_Z = 128 * MiB, WS_H = 256 * MiB;
constexpr size_t WS_BAR = 3 * MiB + 768 * 1024;
constexpr int LDS_MISC = 131072;
constexpr int LDS_BYTES = 135168;

struct Args {
    const float* x; const float* c; const int* pos; const float* w_ada; const float* b_ada; const float* w_in; const float* sinks;
    const float* w_a; const float* w_b; const float* w_o; const float* ln1g; const float* ln1b; const float* w_gu; const float* w_d;
    const float* ln2g; const float* ln2b; float* out; unsigned char* ws;
};

__device__ __forceinline__ unsigned pk2(float lo, float hi) { return pg8::cvt_pk_bf16(lo, hi); }
__device__ __forceinline__ float bflo(unsigned w) { return __uint_as_float(w << 16); }
__device__ __forceinline__ float bfhi(unsigned w) { return __uint_as_float(w & 0xffff0000u); }
__device__ __forceinline__ float sigmoidf_(float v) { return __builtin_amdgcn_rcpf(1.0f + __builtin_amdgcn_exp2f(-v * LOG2E)); }
__device__ __forceinline__ float wave_sum(float v) {
#pragma unroll
    for (int o = 1; o < 64; o <<= 1) v += __shfl_xor(v, o);
    return v;
}

namespace pg8 {
struct EpiInProj {
    static constexpr bool PERM = true, AFTER_DRAIN = false;
    unsigned char* ws; bf16_t* GA; const f32x4* rope;
    __device__ __forceinline__ void operator()(const f32x4 (&acc)[2][2][4][2], const Unit& u, int wr, int wc, int fr, int fq) const {
        const int pn = u.pn; const int row0 = u.pm * BM + wr * 64 + fr;
        if (pn <= 16) {
            size_t boff; int ldc, cb; float sc = 1.f; bool rope_on = true;
            if (pn < 4) { boff = WS_QA; ldc = 1024; cb = pn * 256; sc = QSCALE; }
            else if (pn == 4) { boff = WS_KVA; ldc = 256; cb = 0; rope_on = (wc < 2); }
            else if (pn < 11) { boff = WS_QB; ldc = 1536; cb = (pn - 5) * 256; sc = QSCALE; }
            else { boff = WS_KB; ldc = 1536; cb = (pn - 11) * 256; }
            bf16_t* base = (bf16_t*)(ws + boff);
            const int col = cb + 64 * wc + 8 * fq;
#pragma unroll
            for (int ai = 0; ai < 2; ++ai)
#pragma unroll
                for (int m = 0; m < 4; ++m) {
                    const int row = row0 + ai * HALF + m * 16;
                    f32x4 a0 = acc[ai][0][m][0], a1 = acc[ai][0][m][1], b0 = acc[ai][1][m][0], b1 = acc[ai][1][m][1];
                    f32x4 o0, o1, p0, p1;
                    if (rope_on) {
                        const f32x4* rp = rope + (size_t)row * 16 + 4 * fq;
                        const f32x4 c0 = rp[0], c1 = rp[1], c2 = rp[2], c3 = rp[3];
                        o0[0] = a0[0] * c0[0] - b0[0] * c0[1]; p0[0] = b0[0] * c0[0] + a0[0] * c0[1];
                        o0[1] = a0[1] * c0[2] - b0[1] * c0[3]; p0[1] = b0[1] * c0[2] + a0[1] * c0[3];
                        o0[2] = a0[2] * c1[0] - b0[2] * c1[1]; p0[2] = b0[2] * c1[0] + a0[2] * c1[1];
                        o0[3] = a0[3] * c1[2] - b0[3] * c1[3]; p0[3] = b0[3] * c1[2] + a0[3] * c1[3];
                        o1[0] = a1[0] * c2[0] - b1[0] * c2[1]; p1[0] = b1[0] * c2[0] + a1[0] * c2[1];
                        o1[1] = a1[1] * c2[2] - b1[1] * c2[3]; p1[1] = b1[1] * c2[2] + a1[1] * c2[3];
                        o1[2] = a1[2] * c3[0] - b1[2] * c3[1]; p1[2] = b1[2] * c3[0] + a1[2] * c3[1];
                        o1[3] = a1[3] * c3[2] - b1[3] * c3[3]; p1[3] = b1[3] * c3[2] + a1[3] * c3[3];
                    } else { o0 = a0; o1 = a1; p0 = b0; p1 = b1; }
                    o0 = o0 * sc; o1 = o1 * sc; p0 = p0 * sc; p1 = p1 * sc;
                    u32x4 w; w.x = cvt_pk_bf16(o0[0], o0[1]); w.y = cvt_pk_bf16(o0[2], o0[3]); w.z = cvt_pk_bf16(o1[0], o1[1]); w.w = cvt_pk_bf16(o1[2], o1[3]);
                    u32x4 v; v.x = cvt_pk_bf16(p0[0], p0[1]); v.y = cvt_pk_bf16(p0[2], p0[3]); v.z = cvt_pk_bf16(p1[0], p1[1]); v.w = cvt_pk_bf16(p1[2], p1[3]);
                    bf16_t* rowp = base + (size_t)row * ldc + col;
                    *(u32x4*)(rowp) = w; *(u32x4*)(rowp + 32) = v;
                }
        } else {
            bf16_t* base; int ldc, cb; const bool sig = (pn >= 23);
            if (pn < 23) { base = (bf16_t*)(ws + WS_VB); ldc = 1536; cb = (pn - 17) * 256; }
            else { base = GA + (pn < 27 ? (size_t)0 : (size_t)M * 1024); ldc = 1024; cb = ((pn - 23) & 3) * 256; }
            const int col = cb + 32 * wc + 8 * fq;
#pragma unroll
            for (int ai = 0; ai < 2; ++ai)
#pragma unroll
                for (int m = 0; m < 4; ++m) {
                    bf16_t* rowp = base + (size_t)(row0 + ai * HALF + m * 16) * ldc + col;
#pragma unroll
                    for (int bj = 0; bj < 2; ++bj) {
                        f32x4 v0 = acc[ai][bj][m][0], v1 = acc[ai][bj][m][1];
                        if (sig) {
#pragma unroll
                            for (int e = 0; e < 4; ++e) { v0[e] = sigmoidf_(v0[e]); v1[e] = sigmoidf_(v1[e]); }
                        }
                        u32x4 w; w.x = cvt_pk_bf16(v0[0], v0[1]); w.y = cvt_pk_bf16(v0[2], v0[3]); w.z = cvt_pk_bf16(v1[0], v1[1]); w.w = cvt_pk_bf16(v1[2], v1[3]);
                        *(u32x4*)(rowp + bj * HALF) = w;
                    }
                }
        }
    }
};
template <bool ADD> struct EpiGate {
    static constexpr bool PERM = true, AFTER_DRAIN = false;
    bf16_t* O; const bf16_t* G; const bf16_t* A;
    __device__ __forceinline__ void operator()(const f32x4 (&acc)[2][2][4][2], const Unit& u, int wr, int wc, int fr, int fq) const {
        const int row0 = u.pm * BM + wr * 64 + fr, col = u.pn * BM + wc * 32 + 8 * fq;
#pragma unroll
        for (int ai = 0; ai < 2; ++ai)
#pragma unroll
            for (int m = 0; m < 4; ++m) {
                const size_t off = (size_t)(row0 + ai * HALF + m * 16) * 1024 + col;
#pragma unroll
                for (int bj = 0; bj < 2; ++bj) {
                    const u32x4 g = *(const u32x4*)(G + off + bj * HALF);
                    f32x4 v0 = acc[ai][bj][m][0], v1 = acc[ai][bj][m][1];
                    v0[0] *= bflo(g.x); v0[1] *= bfhi(g.x); v0[2] *= bflo(g.y); v0[3] *= bfhi(g.y);
                    v1[0] *= bflo(g.z); v1[1] *= bfhi(g.z); v1[2] *= bflo(g.w); v1[3] *= bfhi(g.w);
                    if (ADD) { const u32x4 a = *(const u32x4*)(A + off + bj * HALF);
                        v0[0] += bflo(a.x); v0[1] += bfhi(a.x); v0[2] += bflo(a.y); v0[3] += bfhi(a.y);
                        v1[0] += bflo(a.z); v1[1] += bfhi(a.z); v1[2] += bflo(a.w); v1[3] += bfhi(a.w); }
                    u32x4 w; w.x = cvt_pk_bf16(v0[0], v0[1]); w.y = cvt_pk_bf16(v0[2], v0[3]); w.z = cvt_pk_bf16(v1[0], v1[1]); w.w = cvt_pk_bf16(v1[2], v1[3]);
                    *(u32x4*)(O + off + bj * HALF) = w;
                }
            }
    }
};
template <bool LNIN> struct EpiRes {
    static constexpr bool PERM = true, AFTER_DRAIN = false;
    const float* xin; const bf16_t* zin; bf16_t* zout; const float* gate  ; f32x2v* stats; const f32x2v* rstat; const float* lng; const float* lnb;
    __device__ __forceinline__ void operator()(const f32x4 (&acc)[2][2][4][2], const Unit& u, int wr, int wc, int fr, int fq) const {
        const int row0 = u.pm * BM + wr * 64 + fr, col0 = u.pn * BM + wc * 32 + 8 * fq;
        const float* gb = gate + (size_t)((u.pm * BM) / T) * MODW + col0;
        f32x4 gv[2][2], lg[2][2], lb[2][2];
#pragma unroll
        for (int bj = 0; bj < 2; ++bj)
#pragma unroll
            for (int n = 0; n < 2; ++n) { gv[bj][n] = *(const f32x4*)(gb + bj * HALF + n * 4) + 1.0f;
                if (LNIN) { lg[bj][n] = *(const f32x4*)(lng + col0 + bj * HALF + n * 4); lb[bj][n] = *(const f32x4*)(lnb + col0 + bj * HALF + n * 4); } }
#pragma unroll
        for (int ai = 0; ai < 2; ++ai)
#pragma unroll
            for (int m = 0; m < 4; ++m) {
                const int row = row0 + ai * HALF + m * 16; const size_t off = (size_t)row * 1024 + col0;
                f32x2v rs; if (LNIN) rs = rstat[row];
                float s = 0.f, q = 0.f;
#pragma unroll
                for (int bj = 0; bj < 2; ++bj) {
                    f32x4 x0, x1;
                    if (LNIN) { const u32x4 zz = *(const u32x4*)(zin + off + bj * HALF);
                        x0 = (f32x4){bflo(zz.x), bfhi(zz.x), bflo(zz.y), bfhi(zz.y)}; x1 = (f32x4){bflo(zz.z), bfhi(zz.z), bflo(zz.w), bfhi(zz.w)};
                        x0 = (x0 - rs.x) * rs.y * lg[bj][0] + lb[bj][0]; x1 = (x1 - rs.x) * rs.y * lg[bj][1] + lb[bj][1];
                    } else { x0 = *(const f32x4*)(xin + off + bj * HALF); x1 = *(const f32x4*)(xin + off + bj * HALF + 4); }
                    const f32x4 z0 = x0 * ALPHA + gv[bj][0] * acc[ai][bj][m][0], z1 = x1 * ALPHA + gv[bj][1] * acc[ai][bj][m][1];
                    u32x4 w; w.x = cvt_pk_bf16(z0[0], z0[1]); w.y = cvt_pk_bf16(z0[2], z0[3]); w.z = cvt_pk_bf16(z1[0], z1[1]); w.w = cvt_pk_bf16(z1[2], z1[3]);
                    *(u32x4*)(zout + off + bj * HALF) = w;
                    s += ((z0[0] + z0[1]) + (z0[2] + z0[3])) + ((z1[0] + z1[1]) + (z1[2] + z1[3]));
                    q += ((z0[0] * z0[0] + z0[1] * z0[1]) + (z0[2] * z0[2] + z0[3] * z0[3])) + ((z1[0] * z1[0] + z1[1] * z1[1]) + (z1[2] * z1[2] + z1[3] * z1[3]));
                }
                s += __shfl_xor(s, 16); s += __shfl_xor(s, 32); q += __shfl_xor(q, 16); q += __shfl_xor(q, 32);
                if (fq == 0) stats[(size_t)row * 16 + u.pn * 4 + wc] = (f32x2v){s, q};
            }
    }
};
struct EpiSwiGLU {
    static constexpr bool PERM = true, AFTER_DRAIN = false;
    bf16_t* H;
    __device__ __forceinline__ void operator()(const f32x4 (&acc)[2][2][4][2], const Unit& u, int wr, int wc, int fr, int fq) const {
        const int row0 = u.pm * BM + wr * 64 + fr, col = u.pn * HALF + wc * 32 + 8 * fq;
#pragma unroll
        for (int ai = 0; ai < 2; ++ai)
#pragma unroll
            for (int m = 0; m < 4; ++m) {
                f32x4 o[2];
#pragma unroll
                for (int n = 0; n < 2; ++n)
#pragma unroll
                    for (int e = 0; e < 4; ++e) { const float g = acc[ai][0][m][n][e]; o[n][e] = g * sigmoidf_(g) * acc[ai][1][m][n][e]; }
                u32x4 w; w.x = cvt_pk_bf16(o[0][0], o[0][1]); w.y = cvt_pk_bf16(o[0][2], o[0][3]); w.z = cvt_pk_bf16(o[1][0], o[1][1]); w.w = cvt_pk_bf16(o[1][2], o[1][3]);
                *(u32x4*)(H + (size_t)(row0 + ai * HALF + m * 16) * DFF + col) = w;
            }
    }
};
}

__device__ __forceinline__ void p0_transpose_item(const float* W, int K, int N, bf16* WT, int dst_row0, int src_col0, int kb, LAS float* scr, int lane) {
    const int k0 = 64 * kb;
#pragma unroll 8
    for (int i = 0; i < 32; ++i) { const int kk = 2 * i + (lane >> 5); scr[kk * 33 + (lane & 31)] = W[(size_t)(k0 + kk) * N + src_col0 + (lane & 31)]; }
    asm volatile("s_waitcnt lgkmcnt(0)" ::: "memory");
    const int c = lane & 7;
#pragma unroll
    for (int j = 0; j < 4; ++j) { const int n = (lane >> 3) + 8 * j; const LAS float* s = scr + (8 * c) * 33 + n;
        u32x4 o; o.x = pk2(s[0 * 33], s[1 * 33]); o.y = pk2(s[2 * 33], s[3 * 33]); o.z = pk2(s[4 * 33], s[5 * 33]); o.w = pk2(s[6 * 33], s[7 * 33]);
        *(u32x4*)(WT + (size_t)(dst_row0 + n) * K + k0 + 8 * c) = o; }
    asm volatile("s_waitcnt lgkmcnt(0)" ::: "memory");
}
__device__ __forceinline__ int win_src(int p_abs) {
    const int pn = p_abs >> 8, p = p_abs & 255;
    if (pn <= 16) { const int bj = p >> 7, hh = (p & 127) >> 5; return pn * 256 + 64 * hh + 32 * bj; }
    return p_abs;
}
__device__ __forceinline__ int wgu_src(int p_abs) {
    const int pn = p_abs >> 8, p = p_abs & 255, bj = p >> 7, j = p & 127; return bj * DFF + pn * 128 + j;
}

__device__ __forceinline__ void phase0(const Args& a, LAS unsigned char* lds, int wave, int lane) {
    asm volatile("" : "+v"(lane));
    LAS float* scr = (LAS float*)(lds + wave * 16384);
    const int gw = blockIdx.x * NWAVES + wave, NGW = gridDim.x * NWAVES;
    unsigned char* ws = a.ws;
    for (int it = gw; it < 96 * 8; it += NGW) {
        const int cgp = it % 96, kc = it / 96;
        for (int idx = lane; idx < 2048; idx += 64) { const int b = idx >> 7, k = idx & 127; const float cv = a.c[b * D + kc * 128 + k]; scr[idx] = cv * sigmoidf_(cv); }
        asm volatile("s_waitcnt lgkmcnt(0)" ::: "memory");
        float acc[16];
#pragma unroll
        for (int b = 0; b < 16; ++b) acc[b] = 0.f;
        const float* wp = a.w_ada + (size_t)(kc * 128) * MODW + cgp * 64 + lane;
        for (int k = 0; k < 128; k += 4) {
            const float w0 = wp[(size_t)(k + 0) * MODW], w1 = wp[(size_t)(k + 1) * MODW], w2 = wp[(size_t)(k + 2) * MODW], w3 = wp[(size_t)(k + 3) * MODW];
#pragma unroll
            for (int b = 0; b < 16; ++b) { const f32x4 cv = *(const LAS f32x4*)(scr + b * 128 + k); acc[b] += cv[0] * w0 + cv[1] * w1 + cv[2] * w2 + cv[3] * w3; }
        }
        float* mp = (float*)(ws + WS_MODP) + (size_t)kc * 16 * MODW + cgp * 64 + lane;
        const float bias = (kc == 0) ? a.b_ada[cgp * 64 + lane] : 0.f;
#pragma unroll
        for (int b = 0; b < 16; ++b) mp[(size_t)b * MODW] = acc[b] + bias;
        asm volatile("s_waitcnt lgkmcnt(0)" ::: "memory");
    }
    constexpr int I_IN = 16 * 248, I_A = 16 * 32, I_B = 8 * 32, I_O = 16 * 32, I_GU = 16 * 176, I_D = 44 * 32;
    constexpr int NITEMS = I_IN + I_A + I_B + I_O + I_GU + I_D;
    for (int it = gw; it < NITEMS; it += NGW) {
        int r = it;
        if (r < I_IN) { const int nb = r % 248, kb = r / 248; p0_transpose_item(a.w_in, 1024, INW, (bf16*)(ws + WS_WIN), 32 * nb, win_src(32 * nb), kb, scr, lane); continue; } r -= I_IN;
        if (r < I_A) { const int nb = r % 32, kb = r / 32; p0_transpose_item(a.w_a, 1024, 1024, (bf16*)(ws + WS_WA), 32 * nb, 32 * nb, kb, scr, lane); continue; } r -= I_A;
        if (r < I_B) { const int nb = r % 32, kb = r / 32; p0_transpose_item(a.w_b, 512, 1024, (bf16*)(ws + WS_WB), 32 * nb, 32 * nb, kb, scr, lane); continue; } r -= I_B;
        if (r < I_O) { const int nb = r % 32, kb = r / 32; p0_transpose_item(a.w_o, 1024, 1024, (bf16*)(ws + WS_WO), 32 * nb, 32 * nb, kb, scr, lane); continue; } r -= I_O;
        if (r < I_GU) { const int nb = r % 176, kb = r / 176; p0_transpose_item(a.w_gu, 1024, 2 * DFF, (bf16*)(ws + WS_WGU), 32 * nb, wgu_src(32 * nb), kb, scr, lane); continue; } r -= I_GU;
        { const int nb = r % 32, kb = r / 32; p0_transpose_item(a.w_d, DFF, 1024, (bf16*)(ws + WS_WD), 32 * nb, 32 * nb, kb, scr, lane); }
    }
    {
        f32x2v* rope = (f32x2v*)(ws + WS_ROPE);
        const int gt = blockIdx.x * (NWAVES * 64) + threadIdx.x, NT = gridDim.x * NWAVES * 64;
        for (int idx = gt; idx < M * 32; idx += NT) {
            const int row = idx >> 5, i = idx & 31;
            const float inv = exp2f(-(float)i * (13.287712379549449f / 32.0f));
            const float ang = (float)a.pos[row] * inv;
            double rev = (double)ang * 0.15915494309189535; rev -= floor(rev);
            const float fr = (float)rev;
            rope[idx] = (f32x2v){__builtin_amdgcn_cosf(fr), __builtin_amdgcn_sinf(fr)};
        }
    }
}

__device__ __forceinline__ void phase1(const Args& a, LAS unsigned char* lds, int wave, int lane) {
    asm volatile("" : "+v"(lane));
    unsigned char* ws = a.ws; const float* modp = (const float*)(ws + WS_MODP); float* mod = (float*)(ws + WS_MOD);
    const int tid = threadIdx.x;
    for (int idx = blockIdx.x * 512 + tid; idx < 16 * MODW; idx += gridDim.x * 512) {
        float s = 0.f;
#pragma unroll
        for (int kc = 0; kc < 8; ++kc) s += modp[(size_t)kc * 16 * MODW + idx];
        mod[idx] = s;
    }
    LAS float* ss = (LAS float*)lds;
    bf16* U = (bf16*)(ws + WS_U);
    for (int chunk = blockIdx.x; chunk < M / 128; chunk += gridDim.x) {
        const int b = chunk / (T / 128);
        __syncthreads();
        for (int idx = tid; idx < 2048; idx += 512) {
            float s = 0.f;
#pragma unroll
            for (int kc = 0; kc < 8; ++kc) s += modp[(size_t)kc * 16 * MODW + (size_t)b * MODW + idx];
            ss[idx] = s;
        }
        __syncthreads();
        for (int rr = wave; rr < 128; rr += NWAVES) {
            const int row = chunk * 128 + rr;
            const f32x4* xr = (const f32x4*)(a.x + (size_t)row * D) + lane;
            unsigned long long* o8 = (unsigned long long*)(U + (size_t)row * D) + lane;
#pragma unroll
            for (int j = 0; j < 4; ++j) {
                const f32x4 v = xr[64 * j]; const int col = 4 * lane + 256 * j;
                const f32x4 sh = *(const LAS f32x4*)(ss + col), sc = *(const LAS f32x4*)(ss + 1024 + col);
                const f32x4 uu = v * (sc + 1.0f) + sh;
                o8[64 * j] = (unsigned long long)pk2(uu[0], uu[1]) | ((unsigned long long)pk2(uu[2], uu[3]) << 32);
            }
        }
    }
    __syncthreads();
}

__device__ __forceinline__ int crow(int r, int hi) { return (r & 3) + 8 * (r >> 2) + 4 * hi; }
template <bool PROBE> __device__ __forceinline__ void attn_phase(const Args& a, LAS unsigned char* lds, int wave, int lane) {
    asm volatile("" : "+v"(lane));
    unsigned char* ws = a.ws;
    const int r32 = lane & 31, hi = lane >> 5;
    LAS unsigned char* vt = lds + wave * 16384;
    const unsigned vaddr = (unsigned)(uintptr_t)vt + (4 * hi + ((lane & 15) >> 2)) * 64 + ((lane >> 4) & 1) * 32 + (lane & 3) * 8;
    const int vkey = lane >> 3, vch = lane & 7;
    LAS unsigned char* vwr = vt + (vch >> 2) * 2048 + vkey * 64 + (vch & 3) * 16;
    LAS unsigned char* kwr[2];
    kwr[0] = vt + vkey * 128 + ((vch ^ ((vkey >> 1) & 7)) << 4);
    kwr[1] = vt + vkey * 128 + ((vch ^ (((vkey >> 1) + 4) & 7)) << 4);
    LAS unsigned char* krd = vt + r32 * 128; const int kswz = (r32 >> 1) & 7;
    for (int bi = blockIdx.x; bi < 5120; bi += gridDim.x) {
        const int it = bi * 8 + wave;
        const bf16 *Q, *K, *V; bf16* O; int qp, kp, r, res, b, qs, nback; float sink2 = 0.f; bool has_sink; float* lse = nullptr;
        if (it < 16384) {
            const int g = it & 7; qs = (it >> 3) & 63; const int kvh = (it >> 9) & 1; b = it >> 10; r = 1; res = 0;
            const int hq = kvh * 8 + g;
            Q = (const bf16*)(ws + WS_QA) + hq * 64; qp = 1024; K = (const bf16*)(ws + WS_KVA) + kvh * 64; V = K + 128; kp = 256; O = (bf16*)(ws + WS_QA) + hq * 64;
            nback = 127; has_sink = true; sink2 = a.sinks[hq] * LOG2E;
        } else {
            const int it2 = it - 16384, grp = it2 >> 13, it3 = it2 & 8191, j = it3 & 7; b = it3 >> 9;
            if (grp == 0) { qs = (it3 >> 3) & 63; r = 1; res = 0; }
            else if (grp == 1) { qs = (it3 >> 3) & 15; res = (it3 >> 7) & 3; r = 4; }
            else { qs = (it3 >> 3) & 3; res = (it3 >> 5) & 15; r = 16; }
            const int h = grp * 8 + j;
            Q = (const bf16*)(ws + WS_QB) + h * 64; qp = 1536; K = (const bf16*)(ws + WS_KB) + h * 64; V = (const bf16*)(ws + WS_VB) + h * 64; kp = 1536; O = (bf16*)(ws + WS_QB) + h * 64;
            nback = 128; has_sink = false; lse = (float*)(ws + WS_LSE) + (size_t)grp * M * 8 + j;
        }
        const int q0 = qs * 32; const int tokbase = b * T + res;
        const int jstart = q0 >= 128 ? 0 : ((128 - q0) >> 5);
        const size_t qtok = (size_t)(tokbase + r * (q0 + r32));
        bf16x8 qf[4];
#pragma unroll
        for (int d0 = 0; d0 < 4; ++d0) qf[d0] = *(const bf16x8*)(Q + qtok * qp + d0 * 16 + hi * 8);
        const unsigned voff = (unsigned)((r * vkey * kp + vch * 8) * 2);
        const size_t tstride = (size_t)(32 * r) * kp * 2;
        const size_t v8 = (size_t)(8 * r) * kp * 2;
        const long long t0off = ((long long)tokbase + (long long)r * (q0 - 128)) * kp * 2;
        const unsigned char* kb0 = (const unsigned char*)K + t0off;
        const unsigned char* vb0 = (const unsigned char*)V + t0off;
        u32x4 kraw[5][4];
#pragma unroll
        for (int j = 0; j < 5; ++j) {
            const int jj = j >= jstart ? j : jstart;
#pragma unroll
            for (int i4 = 0; i4 < 4; ++i4) kraw[j][i4] = *(const u32x4*)(kb0 + jj * tstride + i4 * v8 + voff);
        }
        u32x4 vv[5][4];
#pragma unroll
        for (int j = 0; j < 5; ++j) {
            const int jj = j >= jstart ? j : jstart;
#pragma unroll
            for (int i4 = 0; i4 < 4; ++i4) vv[j][i4] = *(const u32x4*)(vb0 + jj * tstride + i4 * v8 + voff);
        }
        f32x16 S[5];
#pragma unroll
        for (int j = 0; j < 5; ++j) {
#pragma unroll
            for (int i4 = 0; i4 < 4; ++i4) *(LAS u32x4*)(kwr[i4 & 1] + (j & 3) * 4096 + i4 * 1024) = kraw[j][i4];
            bf16x8 kf[4];
#pragma unroll
            for (int d0 = 0; d0 < 4; ++d0) kf[d0] = *(const LAS bf16x8*)(krd + (j & 3) * 4096 + (((2 * d0 + hi) ^ kswz) << 4));
            f32x16 sacc = {};
#pragma unroll
            for (int d0 = 0; d0 < 4; ++d0) sacc = __builtin_amdgcn_mfma_f32_32x32x16_bf16(kf[d0], qf[d0], sacc, 0, 0, 0);
            S[j] = sacc;
        }
#pragma unroll
        for (int j = 0; j < 4; ++j) {
            const float neg = (j < jstart) ? -INFINITY : INFINITY;
#pragma unroll
            for (int rr = 0; rr < 16; ++rr) S[j][rr] = fminf(S[j][rr], neg);
        }
#pragma unroll
        for (int rr = 0; rr < 16; ++rr) { const int dist = 128 + r32 - crow(rr, hi); if (dist > nback) S[0][rr] = -INFINITY; }
#pragma unroll
        for (int rr = 0; rr < 16; ++rr) { if (r32 - crow(rr, hi) < 0) S[4][rr] = -INFINITY; }
        float mx = -INFINITY;
#pragma unroll
        for (int j = 0; j < 5; ++j) {
#pragma unroll
            for (int rr = 0; rr < 16; ++rr) mx = fmaxf(mx, S[j][rr]);
        }
        mx = fmaxf(mx, __shfl_xor(mx, 32));
        if (has_sink) mx = fmaxf(mx, sink2);
        float ls = 0.f;
#pragma unroll
        for (int j = 0; j < 5; ++j) {
#pragma unroll
            for (int rr = 0; rr < 16; ++rr) { const float p = __builtin_amdgcn_exp2f(S[j][rr] - mx); S[j][rr] = p; ls += p; }
        }
        ls += __shfl_xor(ls, 32);
        if (has_sink) ls += __builtin_amdgcn_exp2f(sink2 - mx);
#pragma unroll
        for (int j = 0; j < 4; ++j) {
#pragma unroll
            for (int i4 = 0; i4 < 4; ++i4) *(LAS u32x4*)(vwr + j * 4096 + i4 * 512) = vv[j][i4];
        }
        f32x16 OT[2]; OT[0] = f32x16{}; OT[1] = f32x16{};
#pragma unroll
        for (int j = 0; j < 5; ++j) {
            if (j == 4) {
#pragma unroll
                for (int i4 = 0; i4 < 4; ++i4) *(LAS u32x4*)(vwr + i4 * 512) = vv[4][i4];
            }
            u32x4 pw[2];
#pragma unroll
            for (int kh = 0; kh < 2; ++kh) { pw[kh].x = pk2(S[j][8 * kh + 0], S[j][8 * kh + 1]); pw[kh].y = pk2(S[j][8 * kh + 2], S[j][8 * kh + 3]); pw[kh].z = pk2(S[j][8 * kh + 4], S[j][8 * kh + 5]); pw[kh].w = pk2(S[j][8 * kh + 6], S[j][8 * kh + 7]); }
            s16x4 lo[2][2], hh[2][2];
            const unsigned va = vaddr + (j & 3) * 4096;
#define TRRD(dst, off) asm volatile("ds_read_b64_tr_b16 %0, %1 offset:" #off : "=&v"(dst) : "v"(va) : "memory")
            TRRD(lo[0][0], 0);    TRRD(hh[0][0], 512);  TRRD(lo[0][1], 1024); TRRD(hh[0][1], 1536);
            TRRD(lo[1][0], 2048); TRRD(hh[1][0], 2560); TRRD(lo[1][1], 3072); TRRD(hh[1][1], 3584);
#undef TRRD
            asm volatile("s_waitcnt lgkmcnt(0)" : "+v"(lo[0][0]), "+v"(lo[0][1]), "+v"(lo[1][0]), "+v"(lo[1][1]), "+v"(hh[0][0]), "+v"(hh[0][1]), "+v"(hh[1][0]), "+v"(hh[1][1]) :: "memory");
#pragma unroll
            for (int db = 0; db < 2; ++db)
#pragma unroll
                for (int kh = 0; kh < 2; ++kh) {
                    const bf16x8 af = (bf16x8){lo[db][kh][0], lo[db][kh][1], lo[db][kh][2], lo[db][kh][3], hh[db][kh][0], hh[db][kh][1], hh[db][kh][2], hh[db][kh][3]};
                    OT[db] = __builtin_amdgcn_mfma_f32_32x32x16_bf16(af, __builtin_bit_cast(bf16x8, pw[kh]), OT[db], 0, 0, 0);
                }
        }
        const float inv_l = 1.0f / ls;
        bf16* op = O + qtok * qp;
        if (PROBE) op = (bf16*)(ws + WS_U + ((size_t)((unsigned char*)op - ws) & (64 * MiB - 1)));
#pragma unroll
        for (int db = 0; db < 2; ++db)
#pragma unroll
            for (int rg = 0; rg < 4; ++rg) {
                u32x2 w; w.x = pk2(OT[db][4 * rg + 0] * inv_l, OT[db][4 * rg + 1] * inv_l); w.y = pk2(OT[db][4 * rg + 2] * inv_l, OT[db][4 * rg + 3] * inv_l);
                *(u32x2*)(op + 32 * db + 8 * rg + 4 * hi) = w;
            }
        if (lse != nullptr && hi == 0) lse[qtok * 8] = mx + __builtin_amdgcn_logf(ls);
    }
}

__device__ __forceinline__ void merge_pass(const Args& a, int wave, int lane) {
    asm volatile("" : "+v"(lane));
    unsigned char* ws = a.ws; const bf16* OG = (const bf16*)(ws + WS_QB); const float* LSE = (const float*)(ws + WS_LSE); bf16* OB = (bf16*)(ws + WS_OB);
    const int gw = blockIdx.x * NWAVES + wave, NGW = gridDim.x * NWAVES; const int j = lane >> 3, ch = lane & 7;
    for (int row = gw; row < M; row += NGW) {
        const float l0 = LSE[(size_t)row * 8 + j], l1 = LSE[(size_t)M * 8 + (size_t)row * 8 + j], l2 = LSE[(size_t)2 * M * 8 + (size_t)row * 8 + j];
        const float mx = fmaxf(l0, fmaxf(l1, l2));
        float e0 = __builtin_amdgcn_exp2f(l0 - mx), e1 = __builtin_amdgcn_exp2f(l1 - mx), e2 = __builtin_amdgcn_exp2f(l2 - mx);
        const float inv = 1.0f / (e0 + e1 + e2); e0 *= inv; e1 *= inv; e2 *= inv;
        const bf16* p = OG + (size_t)row * 1536 + j * 64 + ch * 8;
        const u32x4 a0 = *(const u32x4*)(p), a1 = *(const u32x4*)(p + 512), a2 = *(const u32x4*)(p + 1024);
        u32x4 o;
        o.x = pk2(e0 * bflo(a0.x) + e1 * bflo(a1.x) + e2 * bflo(a2.x), e0 * bfhi(a0.x) + e1 * bfhi(a1.x) + e2 * bfhi(a2.x));
        o.y = pk2(e0 * bflo(a0.y) + e1 * bflo(a1.y) + e2 * bflo(a2.y), e0 * bfhi(a0.y) + e1 * bfhi(a1.y) + e2 * bfhi(a2.y));
        o.z = pk2(e0 * bflo(a0.z) + e1 * bflo(a1.z) + e2 * bflo(a2.z), e0 * bfhi(a0.z) + e1 * bfhi(a1.z) + e2 * bfhi(a2.z));
        o.w = pk2(e0 * bflo(a0.w) + e1 * bflo(a1.w) + e2 * bflo(a2.w), e0 * bfhi(a0.w) + e1 * bfhi(a1.w) + e2 * bfhi(a2.w));
        *(u32x4*)(OB + (size_t)row * 512 + j * 64 + ch * 8) = o;
    }
}

template <bool FIRST> __device__ __forceinline__ void ln_pass(const Args& a, int wave, int lane) {
    asm volatile("" : "+v"(lane));
    unsigned char* ws = a.ws;
    const f32x2v* st = (const f32x2v*)(ws + (FIRST ? WS_ST1 : WS_ST2));
    const bf16* zin = (const bf16*)(ws + (FIRST ? WS_Z : WS_Z2));
    const float* lg = FIRST ? a.ln1g : a.ln2g; const float* lb = FIRST ? a.ln1b : a.ln2b;
    const float* mod = (const float*)(ws + WS_MOD);
    const int gw = blockIdx.x * NWAVES + wave, NGW = gridDim.x * NWAVES;
    for (int row = gw; row < M; row += NGW) {
        f32x2v p = st[(size_t)row * 16 + (lane & 15)];
        float s = p.x, q = p.y;
#pragma unroll
        for (int o = 1; o < 16; o <<= 1) { s += __shfl_xor(s, o); q += __shfl_xor(q, o); }
        const float mean = s * (1.0f / D); const float var = fmaxf(q * (1.0f / D) - mean * mean, 0.f); const float rstd = 1.0f / sqrtf(var + LN_EPS);
        if (FIRST && lane == 0) ((f32x2v*)(ws + WS_RSTAT))[row] = (f32x2v){mean, rstd};
        const int b = row / T;
#pragma unroll
        for (int j = 0; j < 2; ++j) {
            const int col = 8 * lane + 512 * j;
            const u32x4 zz = *(const u32x4*)(zin + (size_t)row * D + col);
            f32x4 z0 = (f32x4){bflo(zz.x), bfhi(zz.x), bflo(zz.y), bfhi(zz.y)}, z1 = (f32x4){bflo(zz.z), bfhi(zz.z), bflo(zz.w), bfhi(zz.w)};
            z0 = (z0 - mean) * rstd * *(const f32x4*)(lg + col) + *(const f32x4*)(lb + col);
            z1 = (z1 - mean) * rstd * *(const f32x4*)(lg + col + 4) + *(const f32x4*)(lb + col + 4);
            if (FIRST) {
                const float* mb = mod + (size_t)b * MODW + col;
                z0 = z0 * (*(const f32x4*)(mb + 4 * D) + 1.0f) + *(const f32x4*)(mb + 3 * D);
                z1 = z1 * (*(const f32x4*)(mb + 4 * D + 4) + 1.0f) + *(const f32x4*)(mb + 3 * D + 4);
                u32x4 w; w.x = pk2(z0[0], z0[1]); w.y = pk2(z0[2], z0[3]); w.z = pk2(z1[0], z1[1]); w.w = pk2(z1[2], z1[3]);
                *(u32x4*)((bf16*)(ws + WS_U) + (size_t)row * D + col) = w;
            } else {
                *(f32x4*)(a.out + (size_t)row * D + col) = z0; *(f32x4*)(a.out + (size_t)row * D + col + 4) = z1;
            }
        }
    }
}

#define XB_TMO      128
#define XB_XCNT(j)  (256  + 64 * (j))
#define XB_XSUB(j)  (1280 + 64 * (j))
#define XB_XGEN(j)  (2304 + 64 * (j))
#define XB_TOP      3328
#define XB_TOPGEN   3392
#define XCD_BAR_WORDS 3456
#define XB_SPIN_CAP (1u << 18)

__device__ __forceinline__ unsigned xb_ld(unsigned* p)              { return __hip_atomic_load(p, __ATOMIC_RELAXED, __HIP_MEMORY_SCOPE_AGENT); }
__device__ __forceinline__ unsigned xb_add(unsigned* p, unsigned v) { return __hip_atomic_fetch_add(p, v, __ATOMIC_RELAXED, __HIP_MEMORY_SCOPE_AGENT); }
__device__ __forceinline__ unsigned xb_xcc_id() { return (unsigned)__builtin_amdgcn_s_getreg((3 << 11) | 20) & 0xFu; }
#define XB_SPIN(cond, bar) do { unsigned _sp = 0; while (cond) { __builtin_amdgcn_s_sleep(1); \
    if ((++_sp & 255u) == 0u) { if (xb_ld(&(bar)[XB_TMO])) break; if (_sp > XB_SPIN_CAP) { atomicAdd(&(bar)[XB_TMO], 1u); break; } } } } while (0)

struct XcdBarrier {
    unsigned* bar; unsigned x;
    volatile LAS unsigned* st;
};

__device__ __forceinline__ XcdBarrier xcd_barrier_post(unsigned* bar, volatile LAS unsigned* st) {
    XcdBarrier b; b.bar = bar; b.x = xb_xcc_id(); b.st = st;
    if (threadIdx.x == 0) (void)xb_add(&bar[XB_XCNT(b.x)], 1u);
    return b;
}
__device__ __forceinline__ void xcd_barrier_complete(unsigned* bar, unsigned x, unsigned& nloc, unsigned& nx) {
    const unsigned G = gridDim.x * gridDim.y * gridDim.z;
    unsigned sum, cnt, mine, sp = 0u;
    for (;;) {
        sum = 0u; cnt = 0u; mine = 0u;
#pragma unroll
        for (unsigned j = 0; j < 16; ++j) { const unsigned c = xb_ld(&bar[XB_XCNT(j)]); sum += c; cnt += (c > 0u) ? 1u : 0u; mine = (j == x) ? c : mine; }
        if (sum == G) break;
        __builtin_amdgcn_s_sleep(1);
        if ((++sp & 255u) == 0u) { if (xb_ld(&bar[XB_TMO])) break; if (sp > XB_SPIN_CAP) { atomicAdd(&bar[XB_TMO], 1u); break; } }
    }
    nloc = mine > 0u ? mine : 1u; nx = cnt > 0u ? cnt : 1u;
}

__device__ __forceinline__ void xcd_barrier(const XcdBarrier& b) {
    asm volatile("s_waitcnt vmcnt(0)" ::: "memory");
    __syncthreads();
    if (threadIdx.x == 0) {
        unsigned* bar = b.bar;
        __builtin_amdgcn_s_waitcnt(0);
        unsigned nloc = b.st[0], nx = b.st[1];
        if (nloc == 0u) { xcd_barrier_complete(bar, b.x, nloc, nx); b.st[0] = nloc; b.st[1] = nx; }
        const unsigned old = xb_add(&bar[XB_XSUB(b.x)], 1u);
        const unsigned gen = old / nloc;
        if (old + 1u == (gen + 1u) * nloc) {
            __builtin_amdgcn_fence(__ATOMIC_RELEASE, "agent");
            asm volatile("s_waitcnt vmcnt(0)" ::: "memory");
            const unsigned og = xb_add(&bar[XB_TOP], 1u);
            const unsigned tg = og / nx;
            if (og + 1u == (tg + 1u) * nx) xb_add(&bar[XB_TOPGEN], 1u);
            else XB_SPIN(xb_ld(&bar[XB_TOPGEN]) == tg, bar);
            __builtin_amdgcn_fence(__ATOMIC_ACQUIRE, "agent");
            xb_add(&bar[XB_XGEN(b.x)], 1u);
            asm volatile("s_waitcnt vmcnt(0)" ::: "memory");
        } else {
            XB_SPIN(xb_ld(&bar[XB_XGEN(b.x)]) == gen, bar);
            __builtin_amdgcn_fence(__ATOMIC_ACQUIRE, "agent");
            asm volatile("s_waitcnt vmcnt(0)" ::: "memory");
        }
    }
    __syncthreads();
}

#ifndef PH_HI
#define PH_HI 99
#endif
#ifdef PROBE_SYNC
#define GSYNC() do { xcd_barrier(bar); xcd_barrier(bar); } while (0)
#else
#define GSYNC() xcd_barrier(bar)
#endif
__global__ void __launch_bounds__(NWAVES * 64, 2) mega_fwd(Args a) {
    extern __shared__ __attribute__((aligned(16))) unsigned char lds_raw[];
    LAS unsigned char* lds = (LAS unsigned char*)lds_raw;
    cg::grid_group grid = cg::this_grid();
    const int tid = threadIdx.x, lane = tid & 63, wave = __builtin_amdgcn_readfirstlane(tid >> 6);
    unsigned char* ws = a.ws;
    bf16* GA = (bf16*)a.out; bf16* GB = GA + (size_t)M * 1024;
    const int G = gridDim.x, c = blockIdx.x;

    if (tid < 2) ((volatile LAS unsigned*)(lds + LDS_MISC))[tid] = 0u;
    if (blockIdx.x == 0) { for (int i = tid; i < XCD_BAR_WORDS; i += NWAVES * 64) ((unsigned*)(ws + WS_BAR))[i] = 0u; }
    phase0(a, lds, wave, lane);
#ifdef PROBE_ELEM
    phase0(a, lds, wave, lane);
#endif
    grid.sync();
    XcdBarrier bar = xcd_barrier_post((unsigned*)(ws + WS_BAR), (volatile LAS unsigned*)(lds + LDS_MISC));
    phase1(a, lds, wave, lane);
#ifdef PROBE_ELEM
    phase1(a, lds, wave, lane);
#endif
    GSYNC();
    {
        pg8::Gemm g{(const bf16*)(ws + WS_U), (const bf16*)(ws + WS_WIN), M, INW, 1024}; pg8::StaticOrder S; S.init(M, INW, G, c);
        pg8::EpiInProj E{ws, GA, (const f32x4*)(ws + WS_ROPE)};
#ifdef PROBE_GEMM
        pg8::gemm_phase<pg8::EpiInProj, pg8::StaticOrder, true, true>(lds, g, S, E);
#endif
        pg8::gemm_phase<pg8::EpiInProj, pg8::StaticOrder, true, true>(lds, g, S, E);
    }
    GSYNC();
#ifdef PROBE_ATTN
    attn_phase<true>(a, lds, wave, lane);
#endif
    attn_phase<false>(a, lds, wave, lane);
    GSYNC();
    merge_pass(a, wave, lane);
#ifdef PROBE_ELEM
    merge_pass(a, wave, lane);
#endif
    {
        pg8::Gemm g{(const bf16*)(ws + WS_QA), (const bf16*)(ws + WS_WA), M, 1024, 1024}; pg8::StaticOrder S; S.init(M, 1024, G, c);
        pg8::EpiGate<false> E{(bf16*)(ws + WS_YAS), GA, nullptr};
#ifdef PROBE_GEMM
        pg8::gemm_phase<pg8::EpiGate<false>, pg8::StaticOrder, true, true>(lds, g, S, E);
#endif
        pg8::gemm_phase<pg8::EpiGate<false>, pg8::StaticOrder, true, true>(lds, g, S, E);
    }
    GSYNC();
    {
        pg8::Gemm g{(const bf16*)(ws + WS_OB), (const bf16*)(ws + WS_WB), M, 1024, 512}; pg8::StaticOrder S; S.init(M, 1024, G, c);
        pg8::EpiGate<true> E{(bf16*)(ws + WS_MERGED), GB, (const bf16*)(ws + WS_YAS)};
#ifdef PROBE_GEMM
        pg8::gemm_phase<pg8::EpiGate<true>, pg8::StaticOrder, true, true>(lds, g, S, E);
#endif
        pg8::gemm_phase<pg8::EpiGate<true>, pg8::StaticOrder, true, true>(lds, g, S, E);
    }
    GSYNC();
    {
        pg8::Gemm g{(const bf16*)(ws + WS_MERGED), (const bf16*)(ws + WS_WO), M, 1024, 1024}; pg8::StaticOrder S; S.init(M, 1024, G, c);
        pg8::EpiRes<false> E{a.x, nullptr, (bf16*)(ws + WS_Z), (const float*)(ws + WS_MOD) + 2 * D, (f32x2v*)(ws + WS_ST1), nullptr, nullptr, nullptr};
#ifdef PROBE_GEMM
        pg8::gemm_phase<pg8::EpiRes<false>, pg8::StaticOrder, true, true>(lds, g, S, E);
#endif
        pg8::gemm_phase<pg8::EpiRes<false>, pg8::StaticOrder, true, true>(lds, g, S, E);
    }
    GSYNC();
    ln_pass<true>(a, wave, lane);
#ifdef PROBE_ELEM
    ln_pass<true>(a, wave, lane);
#endif
    GSYNC();
    {
        pg8::Gemm g{(const bf16*)(ws + WS_U), (const bf16*)(ws + WS_WGU), M, 2 * DFF, 1024}; pg8::StaticOrder S; S.init(M, 2 * DFF, G, c);
        pg8::EpiSwiGLU E{(bf16*)(ws + WS_H)};
#ifdef PROBE_GEMM
        pg8::gemm_phase<pg8::EpiSwiGLU, pg8::StaticOrder, true, true>(lds, g, S, E);
#endif
        pg8::gemm_phase<pg8::EpiSwiGLU, pg8::StaticOrder, true, true>(lds, g, S, E);
    }
    GSYNC();
    {
        pg8::Gemm g{(const bf16*)(ws + WS_H), (const bf16*)(ws + WS_WD), M, 1024, DFF}; pg8::StaticOrder S; S.init(M, 1024, G, c);
        pg8::EpiRes<true> E{nullptr, (const bf16*)(ws + WS_Z), (bf16*)(ws + WS_Z2), (const float*)(ws + WS_MOD) + 5 * D, (f32x2v*)(ws + WS_ST2), (const f32x2v*)(ws + WS_RSTAT), a.ln1g, a.ln1b};
#ifdef PROBE_GEMM
        pg8::gemm_phase<pg8::EpiRes<true>, pg8::StaticOrder, true, true>(lds, g, S, E);
#endif
        pg8::gemm_phase<pg8::EpiRes<true>, pg8::StaticOrder, true, true>(lds, g, S, E);
    }
    GSYNC();
    ln_pass<false>(a, wave, lane);
}

extern "C" void kernel_launch(void* const* d_in, const int* in_sizes, int n_in, void* d_out, int out_size, void* d_ws, size_t ws_size, hipStream_t stream) {
    static int grid = 0;
    if (grid == 0) {
        if (n_in != 16 || in_sizes[0] != M * D || out_size != M * D || ws_size < WS_END) {
            fprintf(stderr, "kernel_launch: unexpected shapes: n_in %d in0 %d out %d ws %zu (need %zu)\n", n_in, n_in > 0 ? in_sizes[0] : -1, out_size, ws_size, (size_t)WS_END); grid = -1; return; }
        int dev = 0, cus = 0, per_cu = 0;
        hipGetDevice(&dev); hipDeviceGetAttribute(&cus, hipDeviceAttributeMultiprocessorCount, dev);
        if (hipFuncSetAttribute((const void*)mega_fwd, hipFuncAttributeMaxDynamicSharedMemorySize, LDS_BYTES) != hipSuccess) { fprintf(stderr, "kernel_launch: hipFuncSetAttribute failed\n"); grid = -1; return; }
        if (hipOccupancyMaxActiveBlocksPerMultiprocessor(&per_cu, (const void*)mega_fwd, NWAVES * 64, LDS_BYTES) != hipSuccess || per_cu < 1) { fprintf(stderr, "kernel_launch: occupancy query failed (%d)\n", per_cu); per_cu = 1; }
        (void)hipGetLastError();
        grid = cus * (per_cu > 1 ? 1 : per_cu);
        if (grid < 8) grid = 8;
    }
    if (grid < 0) return;
    Args a{};
    a.x = (const float*)d_in[0]; a.c = (const float*)d_in[1]; a.pos = (const int*)d_in[2]; a.w_ada = (const float*)d_in[3]; a.b_ada = (const float*)d_in[4];
    a.w_in = (const float*)d_in[5]; a.sinks = (const float*)d_in[6]; a.w_a = (const float*)d_in[7]; a.w_b = (const float*)d_in[8]; a.w_o = (const float*)d_in[9];
    a.ln1g = (const float*)d_in[10]; a.ln1b = (const float*)d_in[11]; a.w_gu = (const float*)d_in[12]; a.w_d = (const float*)d_in[13]; a.ln2g = (const float*)d_in[14]; a.ln2b = (const float*)d_in[15];
    a.out = (float*)d_out; a.ws = (unsigned char*)d_ws;
    void* args[] = {&a};
    hipError_t e = hipLaunchCooperativeKernel((const void*)mega_fwd, dim3(grid), dim3(NWAVES * 64), args, LDS_BYTES, stream);
    if (e != hipSuccess) fprintf(stderr, "kernel_launch: cooperative launch failed: %s (grid %d)\n", hipGetErrorString(e), grid);
}
```
